# Optimizing an MI355X kernel written in HIP

```python
import jax
import jax.numpy as jnp
from jax import lax
import numpy as np

D_MODEL = 1024
BATCH = 4
SEQ = 4096
DEPTH = 1

N_META = 16
HG_HEADS = 8
HG_DK = 128
HG_DV = D_MODEL // HG_HEADS
HG_KWIDTH = HG_HEADS * HG_DK
HG_VWIDTH = HG_HEADS * HG_DV
CHUNK = 64
SUB = 16
POOL_WINDOWS = (2, 4, 8, 16)
POOL_GROUPS = len(POOL_WINDOWS)
POOL_WIDTH = D_MODEL
POOL_GDIM = POOL_WIDTH // POOL_GROUPS
EPS = 1e-6
IN_SIZES = (HG_KWIDTH, HG_KWIDTH, HG_VWIDTH, HG_VWIDTH, POOL_WIDTH, POOL_WIDTH, D_MODEL, D_MODEL)
IN_COLS = sum(IN_SIZES)

kernel_name = 'hybrid_hgrn2_pool_block'


def rms_norm(x, w):
    xf = x.astype(jnp.float32)
    y = xf * lax.rsqrt(jnp.mean(xf * xf, axis=-1, keepdims=True) + EPS)
    return (y * w.astype(jnp.float32)).astype(x.dtype)


def to_chunks(t, dh):
    B = t.shape[0]
    t = jnp.pad(t, ((0, 0), (CHUNK - N_META, 0), (0, 0)))
    n = t.shape[1] // CHUNK
    return t.reshape(B, n, CHUNK, HG_HEADS, dh).transpose(1, 0, 3, 2, 4)


def hgrn2_chunkwise(q, k, v, log_f):
    _, B, H, C, DK = q.shape
    DV = v.shape[-1]
    ns = C // SUB
    causal = jnp.tril(jnp.ones((SUB, SUB), dtype=bool))
    earlier = jnp.tril(jnp.ones((ns, ns), dtype=bool), -1)
    diag = jnp.eye(ns, dtype=jnp.float32)

    def step(S, inp):
        qc, kc, vc, gc = inp
        b = jnp.cumsum(gc, axis=2)
        o_inter = jnp.einsum('bhtk,bhkv->bhtv', qc * jnp.exp(b), S)
        qs = qc.reshape(B, H, ns, SUB, DK)
        ks = kc.reshape(B, H, ns, SUB, DK)
        bs = b.reshape(B, H, ns, SUB, DK)
        ref = bs[:, :, :, 0]
        q_ref = qs * jnp.exp(bs - ref[:, :, :, None])
        expo = jnp.where(earlier[None, None, :, :, None, None],
                         ref[:, :, :, None, None, :] - bs[:, :, None, :, :, :], -jnp.inf)
        k_ref = ks[:, :, None] * jnp.exp(expo)
        a_off = jnp.einsum('bhitk,bhijsk->bhitjs', q_ref, k_ref)
        dexp = jnp.where(causal[:, :, None],
                         bs[:, :, :, :, None, :] - bs[:, :, :, None, :, :], -jnp.inf)
        a_diag = jnp.einsum('bhitk,bhitsk,bhisk->bhits', qs, jnp.exp(dexp), ks)
        a = (a_off + a_diag[:, :, :, :, None, :] * diag[:, None, :, None]).reshape(B, H, C, C)
        o = o_inter + jnp.einsum('bhts,bhsv->bhtv', a, vc)
        b_last = b[:, :, -1]
        S_new = jnp.exp(b_last)[..., None] * S + jnp.einsum(
            'bhsk,bhsv->bhkv', kc * jnp.exp(b_last[:, :, None] - b), vc)
        return S_new, o

    S0 = jnp.zeros((B, H, DK, DV), jnp.float32)
    _, o = lax.scan(step, S0, (q, k, v, log_f))
    return o


def causal_multiscale_pool(u):
    B, L, _ = u.shape
    ug = u.astype(jnp.float32).reshape(B, L, POOL_GROUPS, POOL_GDIM)
    cs = jnp.cumsum(ug, axis=1)
    pos = jnp.arange(L)
    outs = []
    for g, w in enumerate(POOL_WINDOWS):
        c = cs[:, :, g]
        lagged = jnp.pad(c, ((0, 0), (w, 0), (0, 0)))[:, :L]
        cnt = jnp.minimum(pos + 1, w).astype(jnp.float32)[None, :, None]
        outs.append((c - lagged) / cnt - ug[:, :, g])
    return jnp.stack(outs, axis=2)


def setup_inputs(seed: int = 0) -> dict:
    key = jax.random.key(seed)
    ks = jax.random.split(key, 13)
    nrm = jax.random.normal
    d = D_MODEL
    f32 = jnp.float32
    return {
        'x': nrm(ks[0], (BATCH, SEQ, d), f32),
        'meta_tokens': nrm(ks[1], (N_META, d), f32),
        'norm_w': 1.0 + 0.02 * nrm(ks[2], (DEPTH, d), f32),
        'w_in': nrm(ks[3], (DEPTH, d, IN_COLS), f32) * d ** -0.5,
        'b_in': 0.01 * nrm(ks[4], (DEPTH, IN_COLS), f32),
        'lb_logits': 0.1 * nrm(ks[5], (DEPTH + 1, HG_KWIDTH), f32),
        'hg_norm_w': 1.0 + 0.02 * nrm(ks[6], (DEPTH, HG_VWIDTH), f32),
        'pool_w': nrm(ks[7], (DEPTH, POOL_GROUPS, POOL_GDIM, POOL_GDIM), f32) * POOL_GDIM ** -0.5,
        'pool_scale': 1.0 + 0.02 * nrm(ks[8], (DEPTH, POOL_WIDTH), f32),
        'w_down_hg': nrm(ks[9], (DEPTH, HG_VWIDTH, d), f32) * HG_VWIDTH ** -0.5,
        'w_down_pool': nrm(ks[10], (DEPTH, POOL_WIDTH, d), f32) * POOL_WIDTH ** -0.5,
        'w_out': nrm(ks[11], (DEPTH, d, d), f32) * d ** -0.5,
        'final_norm_w': 1.0 + 0.02 * nrm(ks[12], (d,), f32),
    }


def reference(x, meta_tokens, norm_w, w_in, b_in, lb_logits, hg_norm_w, pool_w, pool_scale,
              w_down_hg, w_down_pool, w_out, final_norm_w):
    f32 = jnp.float32
    B = x.shape[0]
    meta = jnp.broadcast_to(meta_tokens.astype(x.dtype)[None], (B, N_META, D_MODEL))
    z = jnp.concatenate([meta, x], axis=1)
    L = z.shape[1]
    lower_bounds = jnp.cumsum(jax.nn.softmax(lb_logits.astype(f32), axis=0), axis=0)
    split_at = np.cumsum(IN_SIZES)[:-1].tolist()
    for l in range(DEPTH):
        h = rms_norm(z, norm_w[l])
        p = (h @ w_in[l] + b_in[l]).astype(f32)
        q, fz, iv, g_hg, u, g_pool, m_hg, m_pool = jnp.split(p, split_at, axis=-1)
        lb = lower_bounds[l]
        log_f = jnp.log(lb + (1.0 - lb) * jax.nn.sigmoid(fz))
        k = (1.0 - lb) * jax.nn.sigmoid(-fz)
        o = hgrn2_chunkwise(to_chunks(q, HG_DK), to_chunks(k, HG_DK),
                            to_chunks(iv, HG_DV), to_chunks(log_f, HG_DK))
        o = o.transpose(1, 0, 3, 2, 4).reshape(B, -1, HG_HEADS, HG_DV)[:, CHUNK - N_META:]
        o = rms_norm(o, hg_norm_w[l].reshape(HG_HEADS, HG_DV)).reshape(B, L, HG_VWIDTH)
        y_hg = (o * jax.nn.silu(g_hg)) @ w_down_hg[l].astype(f32)
        pooled = causal_multiscale_pool(u)
        mixed = jnp.einsum('blgc,gcd->blgd', pooled, pool_w[l].astype(f32)).reshape(B, L, POOL_WIDTH)
        y_pool = (mixed * pool_scale[l].astype(f32) * jax.nn.silu(g_pool)) @ w_down_pool[l].astype(f32)
        merged = jax.nn.sigmoid(m_hg) * y_hg + jax.nn.sigmoid(m_pool) * y_pool
        z = z + (merged @ w_out[l].astype(f32)).astype(z.dtype)
    return rms_norm(z, final_norm_w)[:, N_META:]
```

```cpp
#include <hip/hip_runtime.h>
#include <cstdio>
#include <cstdint>
namespace pg8 {
#define PG8_LAS __attribute__((address_space(3)))
typedef unsigned short bf16_t;
typedef short bf16x8 __attribute__((ext_vector_type(8)));
typedef float f32x4 __attribute__((ext_vector_type(4)));
typedef unsigned u32x4 __attribute__((ext_vector_type(4)));
constexpr int BM = 256, BK = 64, HALF = 128, HTB = HALF * BK * 2  , STAGE_BYTES = 8 * HTB, NXCD = 8, WGM = 8;

__host__ __device__ __forceinline__ int lds_byte(int r, int c) { const int st = (r >> 4) * 2 + (c >> 5), rr = r & 15, cc = c & 31, ob = rr * 64 + cc * 2; return st * 1024 + (ob ^ (((ob >> 9) & 1) << 5)); }
__host__ __device__ __forceinline__ void stage_rc(int b, int& R, int& C) { const int st = b / 1024, sb = b % 1024, swz = sb ^ (((sb >> 9) & 1) << 5); R = (st >> 1) * 16 + swz / 64; C = (st & 1) * 32 + (swz % 64) / 2; }
__host__ __device__ __forceinline__ int perm32(int rho) { const int n = rho >> 4, i = rho & 15; return 8 * (i >> 2) + 4 * n + (i & 3); }

struct Unit { int pm, pn; };
struct Gemm { const bf16_t* A; const bf16_t* Bt; int M, N, K; };

struct StaticOrder {
    int nM, nN, nwg, G, c;
    __host__ __device__ void init(int M, int N, int G_, int c_) { nM = M / BM; nN = N / BM; nwg = nM * nN; G = G_; c = c_; }
    __host__ __device__ bool next(int i, Unit& u) const {
        const long L = (long)i * G + c; if (L >= nwg) return false;
        int wgid = (int)L; { const int q = nwg / NXCD, r = nwg % NXCD, xcd = wgid % NXCD, off = wgid / NXCD; wgid = (xcd < r ? xcd * (q + 1) : r * (q + 1) + (xcd - r) * q) + off; }
        const int nig = WGM * nN, gid = wgid / nig, fm = gid * WGM, gsz = (nM - fm) < WGM ? (nM - fm) : WGM;
        u.pm = fm + ((wgid % nig) % gsz); u.pn = (wgid % nig) / gsz; return true;
    }
    __device__ __forceinline__ void a_ready(const Unit&) const {}
    __device__ __forceinline__ void done(const Unit&) const {}
};

typedef __bf16 bf16x2_t __attribute__((ext_vector_type(2)));
typedef float f32x2_t __attribute__((ext_vector_type(2)));
__device__ __forceinline__ unsigned cvt_pk_bf16(float lo, float hi) { f32x2_t f = {lo, hi}; bf16x2_t r = __builtin_convertvector(f, bf16x2_t); return __builtin_bit_cast(unsigned, r); }
__device__ __forceinline__ float bf_lo(unsigned w) { return __uint_as_float(w << 16); }
__device__ __forceinline__ float bf_hi(unsigned w) { return __uint_as_float(w & 0xffff0000u); }
__device__ __forceinline__ float sigm(float x) { return __builtin_amdgcn_rcpf(1.0f + __expf(-x)); }

template <int ACT> struct EpiBf16 {
    static constexpr bool PERM = true, AFTER_DRAIN = false;
    bf16_t* O; int ldc; const float* bias; int split_cols; size_t split_stride;
    __device__ __forceinline__ void operator()(const f32x4 (&acc)[2][2][4][2], const Unit& u, int wr, int wc, int fr, int fq) const {
        const int row0 = u.pm * BM + wr * 64 + fr; int colt = u.pn * BM; bf16_t* base = O;
        if (split_cols) { const int t = colt / split_cols; base += (size_t)t * split_stride; colt -= t * split_cols; }
        const int col0 = colt + wc * 32 + 8 * fq, bcol0 = u.pn * BM + wc * 32 + 8 * fq;
        f32x4 bv[2][2];
#pragma unroll
        for (int bj = 0; bj < 2; ++bj)
#pragma unroll
            for (int n = 0; n < 2; ++n) bv[bj][n] = bias ? *(const f32x4*)(bias + bcol0 + bj * HALF + 4 * n) : (f32x4){0.f, 0.f, 0.f, 0.f};
#pragma unroll
        for (int ai = 0; ai < 2; ++ai)
#pragma unroll
            for (int m = 0; m < 4; ++m) { bf16_t* rowp = base + (size_t)(row0 + ai * HALF + m * 16) * ldc + col0;
#pragma unroll
                for (int bj = 0; bj < 2; ++bj) { f32x4 v0 = acc[ai][bj][m][0] + bv[bj][0], v1 = acc[ai][bj][m][1] + bv[bj][1];
                    if (ACT == 3) {
#pragma unroll
                        for (int j = 0; j < 4; ++j) { v0[j] = sigm(v0[j]); v1[j] = sigm(v1[j]); } }
                    u32x4 w; w.x = cvt_pk_bf16(v0[0], v0[1]); w.y = cvt_pk_bf16(v0[2], v0[3]); w.z = cvt_pk_bf16(v1[0], v1[1]); w.w = cvt_pk_bf16(v1[2], v1[3]);
                    *(u32x4*)(rowp + bj * HALF) = w; } }
    }
};
template <int MODE> struct EpiGate {
    static constexpr bool PERM = true, AFTER_DRAIN = false;
    bf16_t* O; const bf16_t* G; const bf16_t* Y; int ldc;
    __device__ __forceinline__ void operator()(const f32x4 (&acc)[2][2][4][2], const Unit& u, int wr, int wc, int fr, int fq) const {
        const int row0 = u.pm * BM + wr * 64 + fr, col0 = u.pn * BM + wc * 32 + 8 * fq;
#pragma unroll
        for (int ai = 0; ai < 2; ++ai)
#pragma unroll
            for (int m = 0; m < 4; ++m) { const size_t off = (size_t)(row0 + ai * HALF + m * 16) * ldc + col0;
#pragma unroll
                for (int bj = 0; bj < 2; ++bj) { const u32x4 g = *(const u32x4*)(G + off + bj * HALF); f32x4 v0 = acc[ai][bj][m][0], v1 = acc[ai][bj][m][1];
                    v0[0] *= bf_lo(g.x); v0[1] *= bf_hi(g.x); v0[2] *= bf_lo(g.y); v0[3] *= bf_hi(g.y); v1[0] *= bf_lo(g.z); v1[1] *= bf_hi(g.z); v1[2] *= bf_lo(g.w); v1[3] *= bf_hi(g.w);
                    if (MODE == 1) { const u32x4 y = *(const u32x4*)(Y + off + bj * HALF);
                        v0[0] += bf_lo(y.x); v0[1] += bf_hi(y.x); v0[2] += bf_lo(y.y); v0[3] += bf_hi(y.y); v1[0] += bf_lo(y.z); v1[1] += bf_hi(y.z); v1[2] += bf_lo(y.w); v1[3] += bf_hi(y.w); }
                    u32x4 w; w.x = cvt_pk_bf16(v0[0], v0[1]); w.y = cvt_pk_bf16(v0[2], v0[3]); w.z = cvt_pk_bf16(v1[0], v1[1]); w.w = cvt_pk_bf16(v1[2], v1[3]);
                    *(u32x4*)(O + off + bj * HALF) = w; } }
    }
};
struct EpiRes {
    static constexpr bool PERM = false, AFTER_DRAIN = false;
    const float* base; float* C; int ldc;
    __device__ __forceinline__ void operator()(const f32x4 (&acc)[2][2][4][2], const Unit& u, int wr, int wc, int fr, int fq) const {
        const int row0 = u.pm * BM + wr * 64 + fr, col0 = u.pn * BM + wc * 32 + 4 * fq;
#pragma unroll
        for (int ai = 0; ai < 2; ++ai)
#pragma unroll
            for (int m = 0; m < 4; ++m) { const size_t off = (size_t)(row0 + ai * HALF + m * 16) * ldc + col0;
#pragma unroll
                for (int bj = 0; bj < 2; ++bj)
#pragma unroll
                    for (int n = 0; n < 2; ++n) *(f32x4*)(C + off + bj * HALF + n * 16) = *(const f32x4*)(base + off + bj * HALF + n * 16) + acc[ai][bj][m][n]; }
    }
};
template <class Epi, class Sched, bool ALIGN_EPI = false, bool SP2 = false>
__device__ __forceinline__ void gemm_phase(PG8_LAS unsigned char* lds, const Gemm g, const Sched& S, const Epi& E) {
    const int tid = threadIdx.x, wid = __builtin_amdgcn_readfirstlane(tid >> 6), lane = tid & 63, wr = wid >> 2, wc = wid & 3, fr = lane & 15, fq = lane >> 4;
    const int K = g.K, nt = K / BK;
    unsigned voffA[2], voffB[2];
#pragma unroll
    for (int i = 0; i < 2; ++i) { int R, C; stage_rc(tid * 16 + i * 8192, R, C); const int Rb = Epi::PERM ? ((R & ~31) + perm32(R & 31)) : R;
        voffA[i] = (unsigned)(R * K + C) * 2u; voffB[i] = (unsigned)(Rb * K + C) * 2u; }
    const size_t kstep = (size_t)(BK * 2);
    const size_t hstep = (size_t)HALF * K * 2;
    const size_t tstep = 2 * hstep;
    const unsigned ldsw = (unsigned)wid * 1024u;
    const int aoff = lds_byte(wr * 64 + fr, fq * 8), boff = lds_byte(wc * 32 + fr, fq * 8);
#define PG8_SA(b, h) (((b) * 2 + (h)) * HTB)
#define PG8_SB(b, h) ((4 + (b) * 2 + (h)) * HTB)
#define PG8_STAGE(bufoff, gbase, voff) do { _Pragma("unroll") for (int _i = 0; _i < 2; ++_i) \
        __builtin_amdgcn_global_load_lds((const unsigned*)((const char*)(gbase) + (voff)[_i]), (PG8_LAS unsigned*)(lds + (bufoff) + ldsw + _i * 8192), 16, 0, 0); } while (0)
#define PG8_LDA(dst, b, h) do { _Pragma("unroll") for (int m = 0; m < 4; ++m) _Pragma("unroll") for (int k = 0; k < 2; ++k) dst[m][k] = *(const PG8_LAS bf16x8*)(lds + PG8_SA(b, h) + aoff + m * 2048 + k * 1024); } while (0)
#define PG8_LDB(dst, b, h) do { _Pragma("unroll") for (int n = 0; n < 2; ++n) _Pragma("unroll") for (int k = 0; k < 2; ++k) dst[n][k] = *(const PG8_LAS bf16x8*)(lds + PG8_SB(b, h) + boff + n * 2048 + k * 1024); } while (0)
#define PG8_MMA(ai, bj, At, Bt) do { __builtin_amdgcn_s_setprio(1); _Pragma("unroll") for (int m = 0; m < 4; ++m) _Pragma("unroll") for (int n = 0; n < 2; ++n) _Pragma("unroll") for (int k = 0; k < 2; ++k) \
        acc[ai][bj][m][n] = __builtin_amdgcn_mfma_f32_16x16x32_bf16(Bt[n][k], At[m][k], acc[ai][bj][m][n], 0, 0, 0); __builtin_amdgcn_s_setprio(0); } while (0)
#define PG8_WAIT_V(n) asm volatile("s_waitcnt vmcnt(" #n ")" ::: "memory")
#define PG8_WAIT_L(n) asm volatile("s_waitcnt lgkmcnt(" #n ")" ::: "memory")
#define PG8_BAR __builtin_amdgcn_s_barrier()
#define PG8_SCHED __builtin_amdgcn_sched_barrier(0)
    Unit cur, nxt; int ui = 0;
    if (!S.next(0, cur)) return;
    f32x4 acc[2][2][4][2];
#pragma unroll
    for (int a = 0; a < 2; ++a)
#pragma unroll
        for (int b = 0; b < 2; ++b)
#pragma unroll
            for (int m = 0; m < 4; ++m)
#pragma unroll
                for (int n = 0; n < 2; ++n) acc[a][b][m][n] = (f32x4){0.f, 0.f, 0.f, 0.f};
    bf16x8 At[4][2], B0[2][2], B1[2][2];
    const char* cA = (const char*)g.A + (size_t)cur.pm * tstep; const char* cB = (const char*)g.Bt + (size_t)cur.pn * tstep;
    S.a_ready(cur);
    if constexpr (SP2) {
        PG8_STAGE(PG8_SB(0, 0), cB, voffB); PG8_STAGE(PG8_SB(0, 1), cB + hstep, voffB); PG8_STAGE(PG8_SA(0, 0), cA, voffA); PG8_STAGE(PG8_SA(0, 1), cA + hstep, voffA);
        if (wr == 1) PG8_BAR;
        PG8_WAIT_V(2); PG8_BAR;
        PG8_STAGE(PG8_SB(1, 0), cB + kstep, voffB); PG8_STAGE(PG8_SA(1, 0), cA + kstep, voffA); PG8_STAGE(PG8_SB(1, 1), cB + hstep + kstep, voffB);
        PG8_WAIT_V(6); PG8_BAR;
    } else {
        PG8_STAGE(PG8_SB(0, 0), cB, voffB); PG8_STAGE(PG8_SA(0, 0), cA, voffA); PG8_STAGE(PG8_SB(0, 1), cB + hstep, voffB); PG8_STAGE(PG8_SA(0, 1), cA + hstep, voffA);
        if (wr == 1) PG8_BAR;
        PG8_WAIT_V(4); PG8_BAR;
        PG8_STAGE(PG8_SB(1, 0), cB + kstep, voffB); PG8_STAGE(PG8_SA(1, 0), cA + kstep, voffA); PG8_STAGE(PG8_SB(1, 1), cB + hstep + kstep, voffB);
        PG8_WAIT_V(6); PG8_BAR;
    }
    for (;;) {
        const bool has_next = S.next(ui + 1, nxt);
        const char* nA = has_next ? (const char*)g.A + (size_t)nxt.pm * tstep : cA; const char* nB = has_next ? (const char*)g.Bt + (size_t)nxt.pn * tstep : cB;
        for (int t = 0; t < nt; t += 2) {
            const bool last = (t == nt - 2);
            const char* a1 = cA + (size_t)(t + 1) * kstep;
            const char* a2 = last ? nA : cA + (size_t)(t + 2) * kstep; const char* b2 = last ? nB : cB + (size_t)(t + 2) * kstep;
            const char* a3 = a2 + kstep; const char* b3 = b2 + kstep;
            if (last && has_next) S.a_ready(nxt);
            if constexpr (SP2) {
            PG8_LDB(B0, 0, 0); PG8_LDB(B1, 0, 1); PG8_SCHED; PG8_LDA(At, 0, 0); PG8_STAGE(PG8_SA(1, 1), a1 + hstep, voffA);
            PG8_WAIT_V(8); PG8_WAIT_L(0); PG8_BAR; PG8_MMA(0, 0, At, B0); PG8_MMA(0, 1, At, B1); PG8_BAR; PG8_SCHED;
            PG8_LDA(At, 0, 1); PG8_STAGE(PG8_SB(0, 0), b2, voffB); PG8_STAGE(PG8_SB(0, 1), b2 + hstep, voffB); PG8_STAGE(PG8_SA(0, 0), a2, voffA);
            PG8_WAIT_V(8); PG8_WAIT_L(0); PG8_BAR; PG8_MMA(1, 0, At, B0); PG8_MMA(1, 1, At, B1); PG8_BAR; PG8_SCHED;
            PG8_LDB(B0, 1, 0); PG8_LDB(B1, 1, 1); PG8_SCHED; PG8_LDA(At, 1, 0); PG8_STAGE(PG8_SA(0, 1), a2 + hstep, voffA);
            PG8_WAIT_V(8); PG8_WAIT_L(0); PG8_BAR; PG8_MMA(0, 0, At, B0); PG8_MMA(0, 1, At, B1); PG8_BAR; PG8_SCHED;
            PG8_LDA(At, 1, 1); PG8_STAGE(PG8_SB(1, 0), b3, voffB); PG8_STAGE(PG8_SB(1, 1), b3 + hstep, voffB); PG8_STAGE(PG8_SA(1, 0), a3, voffA);
            PG8_WAIT_V(8); PG8_WAIT_L(0); PG8_BAR; PG8_MMA(1, 0, At, B0); PG8_MMA(1, 1, At, B1); PG8_BAR; PG8_SCHED;
            } else {
            PG8_LDB(B0, 0, 0); PG8_SCHED; PG8_LDA(At, 0, 0); PG8_STAGE(PG8_SA(1, 1), a1 + hstep, voffA);
            PG8_WAIT_L(8); PG8_BAR; PG8_WAIT_L(0); PG8_MMA(0, 0, At, B0); PG8_BAR; PG8_SCHED;
            PG8_LDB(B1, 0, 1); PG8_STAGE(PG8_SB(0, 0), b2, voffB);
            PG8_BAR; PG8_WAIT_L(0); PG8_MMA(0, 1, At, B1); PG8_BAR;
            PG8_LDA(At, 0, 1); PG8_STAGE(PG8_SA(0, 0), a2, voffA);
            PG8_BAR; PG8_WAIT_L(0); PG8_MMA(1, 0, At, B0); PG8_BAR; PG8_SCHED;
            PG8_STAGE(PG8_SB(0, 1), b2 + hstep, voffB);
            PG8_WAIT_V(6); PG8_BAR; PG8_MMA(1, 1, At, B1); PG8_BAR;
            PG8_LDB(B0, 1, 0); PG8_SCHED; PG8_LDA(At, 1, 0); PG8_STAGE(PG8_SA(0, 1), a2 + hstep, voffA);
            PG8_WAIT_L(8); PG8_BAR; PG8_WAIT_L(0); PG8_MMA(0, 0, At, B0); PG8_BAR; PG8_SCHED;
            PG8_LDB(B1, 1, 1); PG8_STAGE(PG8_SB(1, 0), b3, voffB);
            PG8_BAR; PG8_WAIT_L(0); PG8_MMA(0, 1, At, B1); PG8_BAR;
            PG8_LDA(At, 1, 1); PG8_STAGE(PG8_SA(1, 0), a3, voffA);
            PG8_BAR; PG8_WAIT_L(0); PG8_MMA(1, 0, At, B0); PG8_BAR; PG8_SCHED;
            PG8_STAGE(PG8_SB(1, 1), b3 + hstep, voffB);
            PG8_WAIT_V(6); PG8_BAR; PG8_MMA(1, 1, At, B1); PG8_BAR;
            }
        }
        if constexpr (ALIGN_EPI) { if (wr == 0) PG8_BAR; }
        if constexpr (!Epi::AFTER_DRAIN) { E(acc, cur, wr, wc, fr, fq); S.done(cur); }
        if (!has_next) break;
#pragma unroll
        for (int a = 0; a < 2; ++a)
#pragma unroll
            for (int b = 0; b < 2; ++b)
#pragma unroll
                for (int m = 0; m < 4; ++m)
#pragma unroll
                    for (int n = 0; n < 2; ++n) acc[a][b][m][n] = (f32x4){0.f, 0.f, 0.f, 0.f};
        cur = nxt; cA = nA; cB = nB; ++ui;
        if constexpr (ALIGN_EPI) { if (wr == 1) PG8_BAR; }
    }
    PG8_WAIT_V(0);
    if constexpr (!ALIGN_EPI) { if (wr == 0) PG8_BAR; }
    PG8_BAR;
    if constexpr (Epi::AFTER_DRAIN) { E.fused(acc, cur, wr, wc, fr, fq, lds, wid, lane); S.done(cur); }
#undef PG8_SA
#undef PG8_SB
#undef PG8_STAGE
#undef PG8_LDA
#undef PG8_LDB
#undef PG8_MMA
#undef PG8_WAIT_V
#undef PG8_WAIT_L
#undef PG8_BAR
#undef PG8_SCHED
}
}
#ifndef PG8_SP2
#define PG8_SP2 true
#endif
#ifndef PG8_ALIGN
#define PG8_ALIGN true
#endif
constexpr int NWAVES = 8, NT = 512;
constexpr int BATCH = 4, SEQ = 4096, D = 1024, NMETA = 16, M = BATCH * SEQ, NCOL = 8192, NH = 8, DK = 128, DV = 128, CH = 64, NCHUNK = SEQ / CH, NCH_ALL = M / CH;
constexpr float EPSF = 1e-6f;
constexpr size_t MiB = 1u << 20;
constexpr size_t WS_CTL = 0, CTL_ZERO_BYTES = 1 * MiB;
constexpr size_t WS_PMETA = 1 * MiB;
constexpr size_t WS_S0 = 1 * MiB + 512 * 1024;
constexpr size_t WS_DL = 2 * MiB;
constexpr size_t WS_BIASP = 3 * MiB;
constexpr size_t WS_HM = 3 * MiB + 64 * 1024;
constexpr size_t WS_WHG = 4 * MiB, WS_WPOOL = 6 * MiB, WS_WOUT = 8 * MiB;
constexpr size_t WS_WIN = 10 * MiB;
constexpr size_t WS_H = 26 * MiB;
constexpr size_t WS_Q = 58 * MiB, WS_K = 90 * MiB, WS_V = 122 * MiB, WS_SG = 154 * MiB, WS_U = 186 * MiB, WS_SGP = 218 * MiB;
constexpr size_t WS_S1 = WS_Q, WS_S2 = WS_K, WS_MRG = WS_V, WS_Y1 = WS_U, WS_END = 250 * MiB;
constexpr int LDS_BYTES = 147456 + 256, MISC_OFF = 147456;
constexpr int CW_BAR = 4096;

#define GAS __attribute__((address_space(1)))
#define LAS __attribute__((address_space(3)))
typedef unsigned short bf16;
typedef unsigned v4u __attribute__((ext_vector_type(4)));
typedef unsigned v2u __attribute__((ext_vector_type(2)));
typedef float f32x4 __attribute__((ext_vector_type(4)));
#define LDS_WAIT() asm volatile("s_waitcnt lgkmcnt(0)" ::: "memory")
__device__ __forceinline__ unsigned f2bf(float f) { unsigned u = __builtin_bit_cast(unsigned, f); return (u + 0x7fffu + ((u >> 16) & 1u)) >> 16; }
__device__ __forceinline__ unsigned pk2(float lo, float hi) { return f2bf(lo) | (f2bf(hi) << 16); }
__device__ __forceinline__ float bf2f(bf16 b) { return __uint_as_float(((unsigned)b) << 16); }
__device__ __forceinline__ float blo(unsigned w) { return __uint_as_float(w << 16); }
__device__ __forceinline__ float bhi(unsigned w) { return __uint_as_float(w & 0xffff0000u); }
__device__ __forceinline__ float sigmf(float x) { return 1.0f / (1.0f + __expf(-x)); }
__device__ __forceinline__ float wave_sum(float v) {
#pragma unroll
    for (int o = 1; o < 64; o <<= 1) v += __shfl_xor(v, o);
    return v;
}
__device__ __forceinline__ void p0_transpose_item(const float* W, int K, int ldw, int nblk, bf16* WT, int row_off, LAS float* scr, int item, int lane) {
    const int kb = item / nblk, nb = item % nblk, k0 = 64 * kb, n0 = 32 * nb;
#pragma unroll 8
    for (int i = 0; i < 32; ++i) { const int kk = 2 * i + (lane >> 5); scr[kk * 33 + (lane & 31)] = W[(size_t)(k0 + kk) * ldw + n0 + (lane & 31)]; }
    LDS_WAIT(); asm volatile("" ::: "memory");
    const int c = lane & 7;
#pragma unroll
    for (int j = 0; j < 4; ++j) { const int n = (lane >> 3) + 8 * j; const LAS float* s = scr + (8 * c) * 33 + n;
        v4u o; o.x = pk2(s[0 * 33], s[1 * 33]); o.y = pk2(s[2 * 33], s[3 * 33]); o.z = pk2(s[4 * 33], s[5 * 33]); o.w = pk2(s[6 * 33], s[7 * 33]);
        *(GAS v4u*)(WT + (size_t)(row_off + n0 + n) * K + k0 + 8 * c) = o; }
    LDS_WAIT(); asm volatile("" ::: "memory");
}
__device__ __forceinline__ void rms_row_to_bf16(const float* xrow, const float* w, bf16* orow, int lane) {
    const GAS f32x4* xr = (const GAS f32x4*)xrow + lane; const GAS f32x4* wr = (const GAS f32x4*)w + lane;
    f32x4 v[4]; float s = 0.f;
#pragma unroll
    for (int j = 0; j < 4; ++j) { v[j] = xr[64 * j]; s += (v[j].x * v[j].x + v[j].y * v[j].y) + (v[j].z * v[j].z + v[j].w * v[j].w); }
    const float r = 1.f / sqrtf(wave_sum(s) * (1.f / D) + EPSF);
    GAS unsigned long long* o8 = (GAS unsigned long long*)orow + lane;
#pragma unroll
    for (int j = 0; j < 4; ++j) { const f32x4 ww = wr[64 * j];
        o8[64 * j] = (unsigned long long)pk2(v[j].x * r * ww.x, v[j].y * r * ww.y) | ((unsigned long long)pk2(v[j].z * r * ww.z, v[j].w * r * ww.w) << 32); }
}

typedef GAS unsigned gu32;
#define RLX_AGENT __ATOMIC_RELAXED, __HIP_MEMORY_SCOPE_AGENT
#define XB_TMO      128
#define XB_XCNT(j)  (256  + 64 * (j))
#define XB_XSUB(j)  (1280 + 64 * (j))
#define XB_XGEN(j)  (2304 + 64 * (j))
#define XB_TOP      3328
#define XB_TOPGEN   3392
#define XCD_BAR_WORDS 3456
#define XB_SPIN_CAP (1u << 18)

__device__ __forceinline__ unsigned xb_ld(unsigned* p)              { return __hip_atomic_load(p, __ATOMIC_RELAXED, __HIP_MEMORY_SCOPE_AGENT); }
__device__ __forceinline__ unsigned xb_add(unsigned* p, unsigned v) { return __hip_atomic_fetch_add(p, v, __ATOMIC_RELAXED, __HIP_MEMORY_SCOPE_AGENT); }
__device__ __forceinline__ unsigned xb_xcc_id() { return (unsigned)__builtin_amdgcn_s_getreg((3 << 11) | 20) & 0xFu; }
#define XB_SPIN(cond, bar) do { unsigned _sp = 0; while (cond) { __builtin_amdgcn_s_sleep(1); \
    if ((++_sp & 255u) == 0u) { if (xb_ld(&(bar)[XB_TMO])) break; if (_sp > XB_SPIN_CAP) { atomicAdd(&(bar)[XB_TMO], 1u); break; } } } } while (0)

struct XcdBarrier {
    unsigned* bar; unsigned x;
    volatile LAS unsigned* st;
};

__device__ __forceinline__ XcdBarrier xcd_barrier_post(unsigned* bar, volatile LAS unsigned* st) {
    XcdBarrier b; b.bar = bar; b.x = xb_xcc_id(); b.st = st;
    if (threadIdx.x == 0) (void)xb_add(&bar[XB_XCNT(b.x)], 1u);
    return b;
}
__device__ __forceinline__ void xcd_barrier_complete(unsigned* bar, unsigned x, unsigned& nloc, unsigned& nx) {
    const unsigned G = gridDim.x * gridDim.y * gridDim.z;
    unsigned sum, cnt, mine, sp = 0u;
    for (;;) {
        sum = 0u; cnt = 0u; mine = 0u;
#pragma unroll
        for (unsigned j = 0; j < 16; ++j) { const unsigned c = xb_ld(&bar[XB_XCNT(j)]); sum += c; cnt += (c > 0u) ? 1u : 0u; mine = (j == x) ? c : mine; }
        if (sum == G) break;
        __builtin_amdgcn_s_sleep(1);
        if ((++sp & 255u) == 0u) { if (xb_ld(&bar[XB_TMO])) break; if (sp > XB_SPIN_CAP) { atomicAdd(&bar[XB_TMO], 1u); break; } }
    }
    nloc = mine > 0u ? mine : 1u; nx = cnt > 0u ? cnt : 1u;
}

__device__ __forceinline__ void xcd_barrier(const XcdBarrier& b) {
    asm volatile("s_waitcnt vmcnt(0)" ::: "memory");
    __syncthreads();
    if (threadIdx.x == 0) {
        unsigned* bar = b.bar;
        __builtin_amdgcn_s_waitcnt(0);
        unsigned nloc = b.st[0], nx = b.st[1];
        if (nloc == 0u) { xcd_barrier_complete(bar, b.x, nloc, nx); b.st[0] = nloc; b.st[1] = nx; }
        const unsigned old = xb_add(&bar[XB_XSUB(b.x)], 1u);
        const unsigned gen = old / nloc;
        if (old + 1u == (gen + 1u) * nloc) {
            __builtin_amdgcn_fence(__ATOMIC_RELEASE, "agent");
            asm volatile("s_waitcnt vmcnt(0)" ::: "memory");
            const unsigned og = xb_add(&bar[XB_TOP], 1u);
            const unsigned tg = og / nx;
            if (og + 1u == (tg + 1u) * nx) xb_add(&bar[XB_TOPGEN], 1u);
            else XB_SPIN(xb_ld(&bar[XB_TOPGEN]) == tg, bar);
            __builtin_amdgcn_fence(__ATOMIC_ACQUIRE, "agent");
            xb_add(&bar[XB_XGEN(b.x)], 1u);
            asm volatile("s_waitcnt vmcnt(0)" ::: "memory");
        } else {
            XB_SPIN(xb_ld(&bar[XB_XGEN(b.x)]) == gen, bar);
            __builtin_amdgcn_fence(__ATOMIC_ACQUIRE, "agent");
            asm volatile("s_waitcnt vmcnt(0)" ::: "memory");
        }
    }
    __syncthreads();
}

struct Args { const float* in[13]; float* out; unsigned char* ws; int ph_lo, ph_hi; };

__global__ void __launch_bounds__(NT, 2) fwd(Args a) {
    extern __shared__ __attribute__((aligned(16))) unsigned char lds[];
    LAS unsigned char* L = (LAS unsigned char*)lds;
    const int tid = threadIdx.x, lane = tid & 63, wave = __builtin_amdgcn_readfirstlane(tid >> 6), G = gridDim.x, bx = blockIdx.x;
    const int gw = bx * NWAVES + wave, NGW = G * NWAVES;
    unsigned char* ws = a.ws;
    const float* x = a.in[0]; const float* meta = a.in[1]; const float* norm_w = a.in[2]; const float* w_in = a.in[3]; const float* b_in = a.in[4];
    const float* lb_logits = a.in[5]; const float* hg_norm_w = a.in[6]; const float* pool_w = a.in[7]; const float* pool_scale = a.in[8];
    const float* w_hg = a.in[9]; const float* w_pool = a.in[10]; const float* w_out = a.in[11]; const float* fin_w = a.in[12];
    float* PMETA = (float*)(ws + WS_PMETA); float* S0 = (float*)(ws + WS_S0); float* DL = (float*)(ws + WS_DL); float* BIASP = (float*)(ws + WS_BIASP);
    bf16* HM = (bf16*)(ws + WS_HM); bf16* WHG = (bf16*)(ws + WS_WHG); bf16* WPOOL = (bf16*)(ws + WS_WPOOL); bf16* WOUT = (bf16*)(ws + WS_WOUT); bf16* WIN = (bf16*)(ws + WS_WIN);
    bf16* Hb = (bf16*)(ws + WS_H); bf16* Qb = (bf16*)(ws + WS_Q); bf16* Kb = (bf16*)(ws + WS_K); bf16* Vb = (bf16*)(ws + WS_V); bf16* SGb = (bf16*)(ws + WS_SG);
    bf16* Ub = (bf16*)(ws + WS_U); bf16* SGPb = (bf16*)(ws + WS_SGP); bf16* S1b = (bf16*)(ws + WS_S1); bf16* S2b = (bf16*)(ws + WS_S2); bf16* MRG = (bf16*)(ws + WS_MRG); bf16* Y1b = (bf16*)(ws + WS_Y1);
    bf16* ST = (bf16*)a.out;
    const int lo = a.ph_lo, hi = a.ph_hi;
    volatile LAS unsigned* MISC = (volatile LAS unsigned*)(L + MISC_OFF);
    if (tid < 64) MISC[tid] = 0u;
    __syncthreads();
    XcdBarrier bar = xcd_barrier_post((unsigned*)(ws + WS_CTL) + CW_BAR, MISC + 8);
#define GRID_BAR(k) do { if (IN(k) && IN((k) + 1)) xcd_barrier(bar); } while (0)
#define IN(k) (lo <= (k) && (k) < hi)

    if (IN(0)) {
        LAS float* scr = (LAS float*)(L + wave * 16384);
        constexpr int I_IN = 16 * 256, I_SQ = 16 * 32;
        for (int it = gw; it < I_IN + 3 * I_SQ; it += NGW) {
            int r = it;
            if (r < I_IN) { const int nb = r % 256; if (nb >= 128 && nb < 160) continue; p0_transpose_item(w_in, D, NCOL, 256, WIN, 0, scr, r, lane); continue; } r -= I_IN;
            if (r < I_SQ) { p0_transpose_item(w_hg, D, D, 32, WHG, 0, scr, r, lane); continue; } r -= I_SQ;
            if (r < I_SQ) { p0_transpose_item(w_pool, D, D, 32, WPOOL, 0, scr, r, lane); continue; } r -= I_SQ;
            p0_transpose_item(w_out, D, D, 32, WOUT, 0, scr, r, lane);
        }
        LAS float* tile = (LAS float*)(L + 131072);
        for (int item = bx; item < 256; item += G) {
            const int g = item >> 6, k0 = 16 * (item & 63);
            __syncthreads();
#pragma unroll
            for (int j = 0; j < 8; ++j) { const int idx = j * NT + tid, kk = idx >> 8, c = idx & 255; tile[idx] = w_in[(size_t)(k0 + kk) * NCOL + 4096 + g * 256 + c]; }
            __syncthreads();
            const int d = tid & 255, kh = tid >> 8;
            float acc[8];
#pragma unroll
            for (int i = 0; i < 8; ++i) acc[i] = 0.f;
            const float* pw = pool_w + (size_t)g * 65536 + d;
            for (int c4 = 0; c4 < 64; ++c4) {
                const float p0 = pw[(4 * c4 + 0) * 256], p1 = pw[(4 * c4 + 1) * 256], p2 = pw[(4 * c4 + 2) * 256], p3 = pw[(4 * c4 + 3) * 256];
#pragma unroll
                for (int i = 0; i < 8; ++i) { const f32x4 t4 = *(const LAS f32x4*)(tile + (kh * 8 + i) * 256 + 4 * c4); acc[i] += (t4.x * p0 + t4.y * p1) + (t4.z * p2 + t4.w * p3); }
            }
            v4u o; o.x = pk2(acc[0], acc[1]); o.y = pk2(acc[2], acc[3]); o.z = pk2(acc[4], acc[5]); o.w = pk2(acc[6], acc[7]);
            *(GAS v4u*)(WIN + (size_t)(4096 + g * 256 + d) * D + k0 + kh * 8) = o;
        }
        { const int n = bx * NT + tid;
          if (n < NCOL) { float bv;
              if (n >= 4096 && n < 5120) { const int g = (n - 4096) >> 8, d = n & 255; float s = 0.f; for (int c = 0; c < 256; ++c) s += b_in[4096 + g * 256 + c] * pool_w[(size_t)g * 65536 + c * 256 + d]; bv = s; }
              else bv = b_in[n];
              BIASP[n] = bv; } }
        for (int m = gw; m < M; m += NGW) rms_row_to_bf16(x + (size_t)m * D, norm_w, Hb + (size_t)m * D, lane);
        if (gw < NMETA) rms_row_to_bf16(meta + (size_t)gw * D, norm_w, HM + (size_t)gw * D, lane);
    }
    GRID_BAR(0);
    if (IN(1)) {
        for (int o = bx * NT + tid; o < NMETA * NCOL; o += G * NT) { const int col = o >> 4, row = o & 15;
            const v4u* wrow = (const v4u*)(WIN + (size_t)col * D); const v4u* hrow = (const v4u*)(HM + (size_t)row * D); float s = 0.f;
            for (int k8 = 0; k8 < 128; ++k8) { const v4u w = wrow[k8], h = hrow[k8];
                s += (blo(w.x) * blo(h.x) + bhi(w.x) * bhi(h.x)) + (blo(w.y) * blo(h.y) + bhi(w.y) * bhi(h.y)) + (blo(w.z) * blo(h.z) + bhi(w.z) * bhi(h.z)) + (blo(w.w) * blo(h.w) + bhi(w.w) * bhi(h.w)); }
            PMETA[(size_t)row * NCOL + col] = s + BIASP[col]; }
        pg8::Gemm g{Hb, WIN, M, 6144, D}; pg8::StaticOrder S; S.init(M, 6144, G, bx);
        pg8::EpiBf16<0> E{Qb, D, BIASP, D, (size_t)(WS_K - WS_Q) / 2};
        pg8::gemm_phase<pg8::EpiBf16<0>, pg8::StaticOrder, PG8_ALIGN, PG8_SP2>(L, g, S, E);
    }
    GRID_BAR(1);
    if (IN(2)) {
        for (int chunk = bx; chunk < NCH_ALL; chunk += G) {
#pragma unroll
            for (int cc = 0; cc < 2; ++cc) { const int col = tid + cc * NT;
                const float lb = 1.0f / (1.0f + __expf(lb_logits[D + col] - lb_logits[col])); float b = 0.f;
                for (int s = 0; s < CH; ++s) { const size_t idx = (size_t)(chunk * CH + s) * D + col;
                    const float q = bf2f(Qb[idx]), fz = bf2f(Kb[idx]); const float sg = sigmf(fz), f = lb + (1.f - lb) * sg;
                    b += __logf(f); const float kk = (1.f - lb) * (1.f - sg);
                    Qb[idx] = (bf16)f2bf(q * __expf(b)); Kb[idx] = (bf16)f2bf(kk * __expf(-b)); }
                DL[(size_t)chunk * D + col] = __expf(b); }
        }
        for (int o = bx * NT + tid; o < NH * DK * DV; o += G * NT) { const int h = o >> 14, k = (o >> 7) & 127, v = o & 127, col = h * 128 + k;
            const float lb = 1.0f / (1.0f + __expf(lb_logits[D + col] - lb_logits[col])); float b = 0.f, s0 = 0.f;
            for (int s = 0; s < NMETA; ++s) { const float fz = PMETA[(size_t)s * NCOL + 1024 + col]; const float sg = sigmf(fz), f = lb + (1.f - lb) * sg;
                b += __logf(f); s0 += (1.f - lb) * (1.f - sg) * __expf(-b) * PMETA[(size_t)s * NCOL + 2048 + h * 128 + v]; }
            S0[o] = __expf(b) * s0; }
        for (int o = bx * NT + tid; o < M * (D / 8); o += G * NT) { const int row = o >> 7, c0 = (o & 127) * 8, i = row & (SEQ - 1), w = 2 << (c0 >> 8);
            float sum[8];
#pragma unroll
            for (int j = 0; j < 8; ++j) sum[j] = 0.f;
            for (int jj = 0; jj < w; ++jj) { const int ii = i - jj;
                if (ii >= 0) { const v4u t = *(const v4u*)(Ub + (size_t)(row - jj) * D + c0);
                    sum[0] += blo(t.x); sum[1] += bhi(t.x); sum[2] += blo(t.y); sum[3] += bhi(t.y); sum[4] += blo(t.z); sum[5] += bhi(t.z); sum[6] += blo(t.w); sum[7] += bhi(t.w); }
                else { const float* pm = PMETA + (size_t)(NMETA + ii) * NCOL + 4096 + c0;
#pragma unroll
                    for (int j = 0; j < 8; ++j) sum[j] += pm[j]; } }
            const v4u cur = *(const v4u*)(Ub + (size_t)row * D + c0); const v4u gp = *(const v4u*)(SGPb + (size_t)row * D + c0);
            const float cu[8] = {blo(cur.x), bhi(cur.x), blo(cur.y), bhi(cur.y), blo(cur.z), bhi(cur.z), blo(cur.w), bhi(cur.w)};
            const float gv[8] = {blo(gp.x), bhi(gp.x), blo(gp.y), bhi(gp.y), blo(gp.z), bhi(gp.z), blo(gp.w), bhi(gp.w)};
            const float inv = 1.0f / (float)w; float r[8];
#pragma unroll
            for (int j = 0; j < 8; ++j) r[j] = (sum[j] * inv - cu[j]) * pool_scale[c0 + j] * (gv[j] * sigmf(gv[j]));
            v4u ov; ov.x = pk2(r[0], r[1]); ov.y = pk2(r[2], r[3]); ov.z = pk2(r[4], r[5]); ov.w = pk2(r[6], r[7]);
            *(v4u*)(SGPb + (size_t)row * D + c0) = ov; }
    }
    GRID_BAR(2);
    if (IN(3)) {
        for (int item = bx; item < BATCH * NH * 8; item += G) { const int bh = item >> 3, sl = item & 7, b = bh >> 3, h = bh & 7;
            const int v = tid & 127, k0 = 16 * sl + (tid >> 7) * 4;
            float s[4];
#pragma unroll
            for (int j = 0; j < 4; ++j) s[j] = S0[(size_t)h * 16384 + (k0 + j) * 128 + v];
            for (int c = 0; c < NCHUNK; ++c) {
                v2u o; o.x = pk2(s[0], s[1]); o.y = pk2(s[2], s[3]);
                *(v2u*)(ST + ((size_t)(bh * NCHUNK + c) * 128 + v) * 128 + k0) = o;
                const size_t r0 = (size_t)(b * SEQ + c * CH); float u[4] = {0.f, 0.f, 0.f, 0.f};
                for (int t = 0; t < CH; ++t) { const v2u kk = *(const v2u*)(Kb + (r0 + t) * D + h * 128 + k0); const float vv = bf2f(Vb[(r0 + t) * D + h * 128 + v]);
                    u[0] += blo(kk.x) * vv; u[1] += bhi(kk.x) * vv; u[2] += blo(kk.y) * vv; u[3] += bhi(kk.y) * vv; }
                const f32x4 dl = *(const f32x4*)(DL + (size_t)(b * NCHUNK + c) * D + h * 128 + k0);
                s[0] = dl.x * (s[0] + u[0]); s[1] = dl.y * (s[1] + u[1]); s[2] = dl.z * (s[2] + u[2]); s[3] = dl.w * (s[3] + u[3]); }
        }
    }
    GRID_BAR(3);
    if (IN(4)) {
        LAS bf16* qs = (LAS bf16*)L; LAS bf16* ks = (LAS bf16*)(L + 16384); LAS bf16* vs = (LAS bf16*)(L + 32768); LAS bf16* Ss = (LAS bf16*)(L + 49152);
        LAS float* Am = (LAS float*)(L + 81920);
        for (int unit = bx; unit < BATCH * NH * NCHUNK; unit += G) { const int c = unit & 63, bh = unit >> 6, b = bh >> 3, h = bh & 7; const size_t r0 = (size_t)(b * SEQ + c * CH);
            __syncthreads();
#pragma unroll
            for (int j = 0; j < 2; ++j) { const int p = j * NT + tid, row = p >> 4, ch = p & 15; const size_t go = (r0 + row) * D + h * 128 + ch * 8;
                *(LAS v4u*)(qs + row * 128 + ch * 8) = *(const v4u*)(Qb + go); *(LAS v4u*)(ks + row * 128 + ch * 8) = *(const v4u*)(Kb + go); *(LAS v4u*)(vs + row * 128 + ch * 8) = *(const v4u*)(Vb + go); }
#pragma unroll
            for (int j = 0; j < 4; ++j) { const int p = j * NT + tid; *(LAS v4u*)(Ss + p * 8) = *(const v4u*)(ST + (size_t)unit * 16384 + p * 8); }
            __syncthreads();
#pragma unroll 1
            for (int j = 0; j < 8; ++j) { const int idx = tid * 8 + j, t = idx >> 6, s = idx & 63; float av = 0.f;
                if (s <= t) { for (int k = 0; k < 128; ++k) av += bf2f(qs[t * 128 + k]) * bf2f(ks[s * 128 + k]); }
                Am[idx] = av; }
            __syncthreads();
            const int t = tid >> 3, v0 = (tid & 7) * 16; float o[16]; float ssq = 0.f;
#pragma unroll 1
            for (int j = 0; j < 16; ++j) { const int v = v0 + j; float ov = 0.f;
                for (int k = 0; k < 128; ++k) ov += bf2f(qs[t * 128 + k]) * bf2f(Ss[v * 128 + k]);
                for (int s = 0; s <= t; ++s) ov += Am[t * 64 + s] * bf2f(vs[s * 128 + v]);
                o[j] = ov; ssq += ov * ov; }
            ssq += __shfl_xor(ssq, 1); ssq += __shfl_xor(ssq, 2); ssq += __shfl_xor(ssq, 4);
            const float rr = 1.f / sqrtf(ssq * (1.f / 128.f) + EPSF);
            bf16* gp = SGb + (r0 + t) * D + h * 128 + v0;
#pragma unroll
            for (int j = 0; j < 16; j += 2) { const unsigned gw2 = *(const unsigned*)(gp + j); const float g0 = blo(gw2), g1 = bhi(gw2);
                *(unsigned*)(gp + j) = pk2(o[j] * rr * hg_norm_w[h * 128 + v0 + j] * (g0 * sigmf(g0)), o[j + 1] * rr * hg_norm_w[h * 128 + v0 + j + 1] * (g1 * sigmf(g1))); }
        }
    }
    GRID_BAR(4);
    if (IN(5)) {
        pg8::Gemm g{Hb, WIN + (size_t)6144 * D, M, 2048, D}; pg8::StaticOrder S; S.init(M, 2048, G, bx);
        pg8::EpiBf16<3> E{S1b, D, BIASP + 6144, D, (size_t)(WS_S2 - WS_S1) / 2};
        pg8::gemm_phase<pg8::EpiBf16<3>, pg8::StaticOrder, PG8_ALIGN, PG8_SP2>(L, g, S, E);
    }
    GRID_BAR(5);
    if (IN(6)) {
        pg8::Gemm g{SGb, WHG, M, D, D}; pg8::StaticOrder S; S.init(M, D, G, bx);
        pg8::EpiGate<0> E{Y1b, S1b, nullptr, D};
        pg8::gemm_phase<pg8::EpiGate<0>, pg8::StaticOrder, PG8_ALIGN, PG8_SP2>(L, g, S, E);
    }
    GRID_BAR(6);
    if (IN(7)) {
        pg8::Gemm g{SGPb, WPOOL, M, D, D}; pg8::StaticOrder S; S.init(M, D, G, bx);
        pg8::EpiGate<1> E{MRG, S2b, Y1b, D};
        pg8::gemm_phase<pg8::EpiGate<1>, pg8::StaticOrder, PG8_ALIGN, PG8_SP2>(L, g, S, E);
    }
    GRID_BAR(7);
    if (IN(8)) {
        pg8::Gemm g{MRG, WOUT, M, D, D}; pg8::StaticOrder S; S.init(M, D, G, bx);
        pg8::EpiRes E{x, a.out, D};
        pg8::gemm_phase<pg8::EpiRes, pg8::StaticOrder, PG8_ALIGN, PG8_SP2>(L, g, S, E);
    }
    GRID_BAR(8);
    if (IN(9)) {
        for (int m = gw; m < M; m += NGW) { GAS f32x4* zr = (GAS f32x4*)(a.out + (size_t)m * D) + lane; const GAS f32x4* wr = (const GAS f32x4*)fin_w + lane;
            f32x4 v[4]; float s = 0.f;
#pragma unroll
            for (int j = 0; j < 4; ++j) { v[j] = zr[64 * j]; s += (v[j].x * v[j].x + v[j].y * v[j].y) + (v[j].z * v[j].z + v[j].w * v[j].w); }
            const float ms = wave_sum(s) * (1.f / D); const float r = 1.f / sqrtf(ms + EPSF);
#pragma unroll
            for (int j = 0; j < 4; ++j) zr[64 * j] = v[j] * r * wr[64 * j]; }
    }

#undef IN
}

constexpr int N_PHASES = 10;
extern "C" void kernel_launch(void* const* d_in, const int* in_sizes, int n_in, void* d_out, int out_size, void* d_ws, size_t ws_size, hipStream_t stream) {
    static int grid = 0;
    if (grid == 0) {
        if (n_in != 13 || out_size != M * D || ws_size < WS_END) { fprintf(stderr, "kernel_launch: unexpected shapes n_in %d out %d ws %zu\n", n_in, out_size, ws_size); grid = -1; return; }
        if (hipFuncSetAttribute((const void*)fwd, hipFuncAttributeMaxDynamicSharedMemorySize, LDS_BYTES) != hipSuccess) { fprintf(stderr, "kernel_launch: hipFuncSetAttribute failed\n"); grid = -1; return; }
        int dev = 0, cus = 0; if (hipGetDevice(&dev) != hipSuccess || hipDeviceGetAttribute(&cus, hipDeviceAttributeMultiprocessorCount, dev) != hipSuccess || cus < 8) { fprintf(stderr, "kernel_launch: device query failed\n"); grid = -1; return; }
        grid = cus;
    }
    if (grid < 0) return;
    Args a{};
    for (int i = 0; i < 13; ++i) a.in[i] = (const float*)d_in[i];
    a.out = (float*)d_out; a.ws = (unsigned char*)d_ws;
    if (hipMemsetAsync((char*)d_ws + WS_CTL, 0, CTL_ZERO_BYTES, stream) != hipSuccess) { fprintf(stderr, "kernel_launch: memset failed\n"); return; }
    a.ph_lo = 0; a.ph_hi = N_PHASES;
    hipLaunchKernelGGL(fwd, dim3(grid), dim3(NT), LDS_BYTES, stream, a);
}
```

```cpp
#include <hip/hip_runtime.h>
#include <cstdio>
#include <cstdint>
namespace pg8 {
#define PG8_LAS __attribute__((address_space(3)))
typedef unsigned short bf16_t;
typedef short bf16x8 __attribute__((ext_vector_type(8)));
typedef float f32x4 __attribute__((ext_vector_type(4)));
typedef unsigned u32x4 __attribute__((ext_vector_type(4)));
constexpr int BM = 256, BK = 64, HALF = 128, HTB = HALF * BK * 2  , STAGE_BYTES = 8 * HTB, NXCD = 8, WGM = 8;

__host__ __device__ __forceinline__ int lds_byte(int r, int c) { const int st = (r >> 4) * 2 + (c >> 5), rr = r & 15, cc = c & 31, ob = rr * 64 + cc * 2; return st * 1024 + (ob ^ (((ob >> 9) & 1) << 5)); }
__host__ __device__ __forceinline__ void stage_rc(int b, int& R, int& C) { const int st = b / 1024, sb = b % 1024, swz = sb ^ (((sb >> 9) & 1) << 5); R = (st >> 1) * 16 + swz / 64; C = (st & 1) * 32 + (swz % 64) / 2; }
__host__ __device__ __forceinline__ int perm32(int rho) { const int n = rho >> 4, i = rho & 15; return 8 * (i >> 2) + 4 * n + (i & 3); }

struct Unit { int pm, pn; };
struct Gemm { const bf16_t* A; const bf16_t* Bt; int M, N, K; };

struct StaticOrder {
    int nM, nN, nwg, G, c;
    __host__ __device__ void init(int M, int N, int G_, int c_) { nM = M / BM; nN = N / BM; nwg = nM * nN; G = G_; c = c_; }
    __host__ __device__ bool next(int i, Unit& u) const {
        const long L = (long)i * G + c; if (L >= nwg) return false;
        int wgid = (int)L; { const int q = nwg / NXCD, r = nwg % NXCD, xcd = wgid % NXCD, off = wgid / NXCD; wgid = (xcd < r ? xcd * (q + 1) : r * (q + 1) + (xcd - r) * q) + off; }
        const int nig = WGM * nN, gid = wgid / nig, fm = gid * WGM, gsz = (nM - fm) < WGM ? (nM - fm) : WGM;
        u.pm = fm + ((wgid % nig) % gsz); u.pn = (wgid % nig) / gsz; return true;
    }
    __device__ __forceinline__ void a_ready(const Unit&) const {}
    __device__ __forceinline__ void done(const Unit&) const {}
};

typedef __bf16 bf16x2_t __attribute__((ext_vector_type(2)));
typedef float f32x2_t __attribute__((ext_vector_type(2)));
__device__ __forceinline__ unsigned cvt_pk_bf16(float lo, float hi) { f32x2_t f = {lo, hi}; bf16x2_t r = __builtin_convertvector(f, bf16x2_t); return __builtin_bit_cast(unsigned, r); }
__device__ __forceinline__ float bf_lo(unsigned w) { return __uint_as_float(w << 16); }
__device__ __forceinline__ float bf_hi(unsigned w) { return __uint_as_float(w & 0xffff0000u); }
__device__ __forceinline__ float sigm(float x) { return __builtin_amdgcn_rcpf(1.0f + __expf(-x)); }

template <int ACT> struct EpiBf16 {
    static constexpr bool PERM = true, AFTER_DRAIN = false;
    bf16_t* O; int ldc; const float* bias; int split_cols; size_t split_stride;
    __device__ __forceinline__ void operator()(const f32x4 (&acc)[2][2][4][2], const Unit& u, int wr, int wc, int fr, int fq) const {
        const int row0 = u.pm * BM + wr * 64 + fr; int colt = u.pn * BM; bf16_t* base = O;
        if (split_cols) { const int t = colt / split_cols; base += (size_t)t * split_stride; colt -= t * split_cols; }
        const int col0 = colt + wc * 32 + 8 * fq, bcol0 = u.pn * BM + wc * 32 + 8 * fq;
        f32x4 bv[2][2];
#pragma unroll
        for (int bj = 0; bj < 2; ++bj)
#pragma unroll
            for (int n = 0; n < 2; ++n) bv[bj][n] = bias ? *(const f32x4*)(bias + bcol0 + bj * HALF + 4 * n) : (f32x4){0.f, 0.f, 0.f, 0.f};
#pragma unroll
        for (int ai = 0; ai < 2; ++ai)
#pragma unroll
            for (int m = 0; m < 4; ++m) { bf16_t* rowp = base + (size_t)(row0 + ai * HALF + m * 16) * ldc + col0;
#pragma unroll
                for (int bj = 0; bj < 2; ++bj) { f32x4 v0 = acc[ai][bj][m][0] + bv[bj][0], v1 = acc[ai][bj][m][1] + bv[bj][1];
                    if (ACT == 3) {
#pragma unroll
                        for (int j = 0; j < 4; ++j) { v0[j] = sigm(v0[j]); v1[j] = sigm(v1[j]); } }
                    u32x4 w; w.x = cvt_pk_bf16(v0[0], v0[1]); w.y = cvt_pk_bf16(v0[2], v0[3]); w.z = cvt_pk_bf16(v1[0], v1[1]); w.w = cvt_pk_bf16(v1[2], v1[3]);
                    *(u32x4*)(rowp + bj * HALF) = w; } }
    }
};
template <int MODE> struct EpiGate {
    static constexpr bool PERM = true, AFTER_DRAIN = false;
    bf16_t* O; const bf16_t* G; const bf16_t* Y; int ldc;
    __device__ __forceinline__ void operator()(const f32x4 (&acc)[2][2][4][2], const Unit& u, int wr, int wc, int fr, int fq) const {
        const int row0 = u.pm * BM + wr * 64 + fr, col0 = u.pn * BM + wc * 32 + 8 * fq;
#pragma unroll
        for (int ai = 0; ai < 2; ++ai)
#pragma unroll
            for (int m = 0; m < 4; ++m) { const size_t off = (size_t)(row0 + ai * HALF + m * 16) * ldc + col0;
#pragma unroll
                for (int bj = 0; bj < 2; ++bj) { const u32x4 g = *(const u32x4*)(G + off + bj * HALF); f32x4 v0 = acc[ai][bj][m][0], v1 = acc[ai][bj][m][1];
                    v0[0] *= bf_lo(g.x); v0[1] *= bf_hi(g.x); v0[2] *= bf_lo(g.y); v0[3] *= bf_hi(g.y); v1[0] *= bf_lo(g.z); v1[1] *= bf_hi(g.z); v1[2] *= bf_lo(g.w); v1[3] *= bf_hi(g.w);
                    if (MODE == 1) { const u32x4 y = *(const u32x4*)(Y + off + bj * HALF);
                        v0[0] += bf_lo(y.x); v0[1] += bf_hi(y.x); v0[2] += bf_lo(y.y); v0[3] += bf_hi(y.y); v1[0] += bf_lo(y.z); v1[1] += bf_hi(y.z); v1[2] += bf_lo(y.w); v1[3] += bf_hi(y.w); }
                    u32x4 w; w.x = cvt_pk_bf16(v0[0], v0[1]); w.y = cvt_pk_bf16(v0[2], v0[3]); w.z = cvt_pk_bf16(v1[0], v1[1]); w.w = cvt_pk_bf16(v1[2], v1[3]);
                    *(u32x4*)(O + off + bj * HALF) = w; } }
    }
};
struct EpiRes {
    static constexpr bool PERM = false, AFTER_DRAIN = false;
    const float* base; float* C; int ldc;
    __device__ __forceinline__ void operator()(const f32x4 (&acc)[2][2][4][2], const Unit& u, int wr, int wc, int fr, int fq) const {
        const int row0 = u.pm * BM + wr * 64 + fr, col0 = u.pn * BM + wc * 32 + 4 * fq;
#pragma unroll
        for (int ai = 0; ai < 2; ++ai)
#pragma unroll
            for (int m = 0; m < 4; ++m) { const size_t off = (size_t)(row0 + ai * HALF + m * 16) * ldc + col0;
#pragma unroll
                for (int bj = 0; bj < 2; ++bj)
#pragma unroll
                    for (int n = 0; n < 2; ++n) *(f32x4*)(C + off + bj * HALF + n * 16) = *(const f32x4*)(base + off + bj * HALF + n * 16) + acc[ai][bj][m][n]; }
    }
};
template <class Epi, class Sched, bool ALIGN_EPI = false, bool SP2 = false>
__device__ __forceinline__ void gemm_phase(PG8_LAS unsigned char* lds, const Gemm g, const Sched& S, const Epi& E) {
    const int tid = threadIdx.x, wid = __builtin_amdgcn_readfirstlane(tid >> 6), lane = tid & 63, wr = wid >> 2, wc = wid & 3, fr = lane & 15, fq = lane >> 4;
    const int K = g.K, nt = K / BK;
    unsigned voffA[2], voffB[2];
#pragma unroll
    for (int i = 0; i < 2; ++i) { int R, C; stage_rc(tid * 16 + i * 8192, R, C); const int Rb = Epi::PERM ? ((R & ~31) + perm32(R & 31)) : R;
        voffA[i] = (unsigned)(R * K + C) * 2u; voffB[i] = (unsigned)(Rb * K + C) * 2u; }
    const size_t kstep = (size_t)(BK * 2);
    const size_t hstep = (size_t)HALF * K * 2;
    const size_t tstep = 2 * hstep;
    const unsigned ldsw = (unsigned)wid * 1024u;
    const int aoff = lds_byte(wr * 64 + fr, fq * 8), boff = lds_byte(wc * 32 + fr, fq * 8);
#define PG8_SA(b, h) (((b) * 2 + (h)) * HTB)
#define PG8_SB(b, h) ((4 + (b) * 2 + (h)) * HTB)
#define PG8_STAGE(bufoff, gbase, voff) do { _Pragma("unroll") for (int _i = 0; _i < 2; ++_i) \
        __builtin_amdgcn_global_load_lds((const unsigned*)((const char*)(gbase) + (voff)[_i]), (PG8_LAS unsigned*)(lds + (bufoff) + ldsw + _i * 8192), 16, 0, 0); } while (0)
#define PG8_LDA(dst, b, h) do { _Pragma("unroll") for (int m = 0; m < 4; ++m) _Pragma("unroll") for (int k = 0; k < 2; ++k) dst[m][k] = *(const PG8_LAS bf16x8*)(lds + PG8_SA(b, h) + aoff + m * 2048 + k * 1024); } while (0)
#define PG8_LDB(dst, b, h) do { _Pragma("unroll") for (int n = 0; n < 2; ++n) _Pragma("unroll") for (int k = 0; k < 2; ++k) dst[n][k] = *(const PG8_LAS bf16x8*)(lds + PG8_SB(b, h) + boff + n * 2048 + k * 1024); } while (0)
#define PG8_MMA(ai, bj, At, Bt) do { __builtin_amdgcn_s_setprio(1); _Pragma("unroll") for (int m = 0; m < 4; ++m) _Pragma("unroll") for (int n = 0; n < 2; ++n) _Pragma("unroll") for (int k = 0; k < 2; ++k) \
        acc[ai][bj][m][n] = __builtin_amdgcn_mfma_f32_16x16x32_bf16(Bt[n][k], At[m][k], acc[ai][bj][m][n], 0, 0, 0); __builtin_amdgcn_s_setprio(0); } while (0)
#define PG8_WAIT_V(n) asm volatile("s_waitcnt vmcnt(" #n ")" ::: "memory")
#define PG8_WAIT_L(n) asm volatile("s_waitcnt lgkmcnt(" #n ")" ::: "memory")
#define PG8_BAR __builtin_amdgcn_s_barrier()
#define PG8_SCHED __builtin_amdgcn_sched_barrier(0)
    Unit cur, nxt; int ui = 0;
    if (!S.next(0, cur)) return;
    f32x4 acc[2][2][4][2];
#pragma unroll
    for (int a = 0; a < 2; ++a)
#pragma unroll
        for (int b = 0; b < 2; ++b)
#pragma unroll
            for (int m = 0; m < 4; ++m)
#pragma unroll
                for (int n = 0; n < 2; ++n) acc[a][b][m][n] = (f32x4){0.f, 0.f, 0.f, 0.f};
    bf16x8 At[4][2], B0[2][2], B1[2][2];
    const char* cA = (const char*)g.A + (size_t)cur.pm * tstep; const char* cB = (const char*)g.Bt + (size_t)cur.pn * tstep;
    S.a_ready(cur);
    if constexpr (SP2) {
        PG8_STAGE(PG8_SB(0, 0), cB, voffB); PG8_STAGE(PG8_SB(0, 1), cB + hstep, voffB); PG8_STAGE(PG8_SA(0, 0), cA, voffA); PG8_STAGE(PG8_SA(0, 1), cA + hstep, voffA);
        if (wr == 1) PG8_BAR;
        PG8_WAIT_V(2); PG8_BAR;
        PG8_STAGE(PG8_SB(1, 0), cB + kstep, voffB); PG8_STAGE(PG8_SA(1, 0), cA + kstep, voffA); PG8_STAGE(PG8_SB(1, 1), cB + hstep + kstep, voffB);
        PG8_WAIT_V(6); PG8_BAR;
    } else {
        PG8_STAGE(PG8_SB(0, 0), cB, voffB); PG8_STAGE(PG8_SA(0, 0), cA, voffA); PG8_STAGE(PG8_SB(0, 1), cB + hstep, voffB); PG8_STAGE(PG8_SA(0, 1), cA + hstep, voffA);
        if (wr == 1) PG8_BAR;
        PG8_WAIT_V(4); PG8_BAR;
        PG8_STAGE(PG8_SB(1, 0), cB + kstep, voffB); PG8_STAGE(PG8_SA(1, 0), cA + kstep, voffA); PG8_STAGE(PG8_SB(1, 1), cB + hstep + kstep, voffB);
        PG8_WAIT_V(6); PG8_BAR;
    }
    for (;;) {
        const bool has_next = S.next(ui + 1, nxt);
        const char* nA = has_next ? (const char*)g.A + (size_t)nxt.pm * tstep : cA; const char* nB = has_next ? (const char*)g.Bt + (size_t)nxt.pn * tstep : cB;
        for (int t = 0; t < nt; t += 2) {
            const bool last = (t == nt - 2);
            const char* a1 = cA + (size_t)(t + 1) * kstep;
            const char* a2 = last ? nA : cA + (size_t)(t + 2) * kstep; const char* b2 = last ? nB : cB + (size_t)(t + 2) * kstep;
            const char* a3 = a2 + kstep; const char* b3 = b2 + kstep;
            if (last && has_next) S.a_ready(nxt);
            if constexpr (SP2) {
            PG8_LDB(B0, 0, 0); PG8_LDB(B1, 0, 1); PG8_SCHED; PG8_LDA(At, 0, 0); PG8_STAGE(PG8_SA(1, 1), a1 + hstep, voffA);
            PG8_WAIT_V(8); PG8_WAIT_L(0); PG8_BAR; PG8_MMA(0, 0, At, B0); PG8_MMA(0, 1, At, B1); PG8_BAR; PG8_SCHED;
            PG8_LDA(At, 0, 1); PG8_STAGE(PG8_SB(0, 0), b2, voffB); PG8_STAGE(PG8_SB(0, 1), b2 + hstep, voffB); PG8_STAGE(PG8_SA(0, 0), a2, voffA);
            PG8_WAIT_V(8); PG8_WAIT_L(0); PG8_BAR; PG8_MMA(1, 0, At, B0); PG8_MMA(1, 1, At, B1); PG8_BAR; PG8_SCHED;
            PG8_LDB(B0, 1, 0); PG8_LDB(B1, 1, 1); PG8_SCHED; PG8_LDA(At, 1, 0); PG8_STAGE(PG8_SA(0, 1), a2 + hstep, voffA);
            PG8_WAIT_V(8); PG8_WAIT_L(0); PG8_BAR; PG8_MMA(0, 0, At, B0); PG8_MMA(0, 1, At, B1); PG8_BAR; PG8_SCHED;
            PG8_LDA(At, 1, 1); PG8_STAGE(PG8_SB(1, 0), b3, voffB); PG8_STAGE(PG8_SB(1, 1), b3 + hstep, voffB); PG8_STAGE(PG8_SA(1, 0), a3, voffA);
            PG8_WAIT_V(8); PG8_WAIT_L(0); PG8_BAR; PG8_MMA(1, 0, At, B0); PG8_MMA(1, 1, At, B1); PG8_BAR; PG8_SCHED;
            } else {
            PG8_LDB(B0, 0, 0); PG8_SCHED; PG8_LDA(At, 0, 0); PG8_STAGE(PG8_SA(1, 1), a1 + hstep, voffA);
            PG8_WAIT_L(8); PG8_BAR; PG8_WAIT_L(0); PG8_MMA(0, 0, At, B0); PG8_BAR; PG8_SCHED;
            PG8_LDB(B1, 0, 1); PG8_STAGE(PG8_SB(0, 0), b2, voffB);
            PG8_BAR; PG8_WAIT_L(0); PG8_MMA(0, 1, At, B1); PG8_BAR;
            PG8_LDA(At, 0, 1); PG8_STAGE(PG8_SA(0, 0), a2, voffA);
            PG8_BAR; PG8_WAIT_L(0); PG8_MMA(1, 0, At, B0); PG8_BAR; PG8_SCHED;
            PG8_STAGE(PG8_SB(0, 1), b2 + hstep, voffB);
            PG8_WAIT_V(6); PG8_BAR; PG8_MMA(1, 1, At, B1); PG8_BAR;
            PG8_LDB(B0, 1, 0); PG8_SCHED; PG8_LDA(At, 1, 0); PG8_STAGE(PG8_SA(0, 1), a2 + hstep, voffA);
            PG8_WAIT_L(8); PG8_BAR; PG8_WAIT_L(0); PG8_MMA(0, 0, At, B0); PG8_BAR; PG8_SCHED;
            PG8_LDB(B1, 1, 1); PG8_STAGE(PG8_SB(1, 0), b3, voffB);
            PG8_BAR; PG8_WAIT_L(0); PG8_MMA(0, 1, At, B1); PG8_BAR;
            PG8_LDA(At, 1, 1); PG8_STAGE(PG8_SA(1, 0), a3, voffA);
            PG8_BAR; PG8_WAIT_L(0); PG8_MMA(1, 0, At, B0); PG8_BAR; PG8_SCHED;
            PG8_STAGE(PG8_SB(1, 1), b3 + hstep, voffB);
            PG8_WAIT_V(6); PG8_BAR; PG8_MMA(1, 1, At, B1); PG8_BAR;
            }
        }
        if constexpr (ALIGN_EPI) { if (wr == 0) PG8_BAR; }
        if constexpr (!Epi::AFTER_DRAIN) { E(acc, cur, wr, wc, fr, fq); S.done(cur); }
        if (!has_next) break;
#pragma unroll
        for (int a = 0; a < 2; ++a)
#pragma unroll
            for (int b = 0; b < 2; ++b)
#pragma unroll
                for (int m = 0; m < 4; ++m)
#pragma unroll
                    for (int n = 0; n < 2; ++n) acc[a][b][m][n] = (f32x4){0.f, 0.f, 0.f, 0.f};
        cur = nxt; cA = nA; cB = nB; ++ui;
        if constexpr (ALIGN_EPI) { if (wr == 1) PG8_BAR; }
    }
    PG8_WAIT_V(0);
    if constexpr (!ALIGN_EPI) { if (wr == 0) PG8_BAR; }
    PG8_BAR;
    if constexpr (Epi::AFTER_DRAIN) { E.fused(acc, cur, wr, wc, fr, fq, lds, wid, lane); S.done(cur); }
#undef PG8_SA
#undef PG8_SB
#undef PG8_STAGE
#undef PG8_LDA
#undef PG8_LDB
#undef PG8_MMA
#undef PG8_WAIT_V
#undef PG8_WAIT_L
#undef PG8_BAR
#undef PG8_SCHED
}
}
#ifndef PG8_SP2
#define PG8_SP2 true
#endif
#ifndef PG8_ALIGN
#define PG8_ALIGN true
#endif
constexpr int NWAVES = 8, NT = 512;
constexpr int BATCH = 4, SEQ = 4096, D = 1024, NMETA = 16, M = BATCH * SEQ, NCOL = 8192, NH = 8, DK = 128, DV = 128, CH = 64, NCHUNK = SEQ / CH, NCH_ALL = M / CH;
constexpr float EPSF = 1e-6f;
constexpr size_t MiB = 1u << 20;
constexpr size_t WS_CTL = 0, CTL_ZERO_BYTES = 1 * MiB;
constexpr size_t WS_PMETA = 1 * MiB;
constexpr size_t WS_S0 = 1 * MiB + 512 * 1024;
constexpr size_t WS_DL = 2 * MiB;
constexpr size_t WS_BIASP = 3 * MiB;
constexpr size_t WS_HM = 3 * MiB + 64 * 1024;
constexpr size_t WS_WHG = 4 * MiB, WS_WPOOL = 6 * MiB, WS_WOUT = 8 * MiB;
constexpr size_t WS_WIN = 10 * MiB;
constexpr size_t WS_H = 26 * MiB;
constexpr size_t WS_Q = 58 * MiB, WS_K = 90 * MiB, WS_V = 122 * MiB, WS_SG = 154 * MiB, WS_U = 186 * MiB, WS_SGP = 218 * MiB;
constexpr size_t WS_S1 = WS_Q, WS_S2 = WS_K, WS_MRG = WS_V, WS_Y1 = WS_U, WS_END = 250 * MiB;
constexpr int LDS_BYTES = 147456 + 256, MISC_OFF = 147456;
constexpr int CW_BAR = 4096;

#define GAS __attribute__((address_space(1)))
#define LAS __attribute__((address_space(3)))
typedef unsigned short bf16;
typedef unsigned v4u __attribute__((ext_vector_type(4)));
typedef unsigned v2u __attribute__((ext_vector_type(2)));
typedef float f32x4 __attribute__((ext_vector_type(4)));
typedef short tr4 __attribute__((ext_vector_type(4)));
#define LDS_WAIT() asm volatile("s_waitcnt lgkmcnt(0)" ::: "memory")
__device__ __forceinline__ unsigned f2bf(float f) { unsigned u = __builtin_bit_cast(unsigned, f); return (u + 0x7fffu + ((u >> 16) & 1u)) >> 16; }
__device__ __forceinline__ unsigned pk2(float lo, float hi) { return f2bf(lo) | (f2bf(hi) << 16); }
__device__ __forceinline__ float bf2f(bf16 b) { return __uint_as_float(((unsigned)b) << 16); }
__device__ __forceinline__ float blo(unsigned w) { return __uint_as_float(w << 16); }
__device__ __forceinline__ float bhi(unsigned w) { return __uint_as_float(w & 0xffff0000u); }
__device__ __forceinline__ float sigmf(float x) { return 1.0f / (1.0f + __expf(-x)); }
__device__ __forceinline__ float wave_sum(float v) {
#pragma unroll
    for (int o = 1; o < 64; o <<= 1) v += __shfl_xor(v, o);
    return v;
}
__device__ __forceinline__ void p0_transpose_item(const float* W, int K, int ldw, int nblk, bf16* WT, int row_off, LAS float* scr, int item, int lane) {
    const int kb = item / nblk, nb = item % nblk, k0 = 64 * kb, n0 = 32 * nb;
#pragma unroll 8
    for (int i = 0; i < 32; ++i) { const int kk = 2 * i + (lane >> 5); scr[kk * 33 + (lane & 31)] = W[(size_t)(k0 + kk) * ldw + n0 + (lane & 31)]; }
    LDS_WAIT(); asm volatile("" ::: "memory");
    const int c = lane & 7;
#pragma unroll
    for (int j = 0; j < 4; ++j) { const int n = (lane >> 3) + 8 * j; const LAS float* s = scr + (8 * c) * 33 + n;
        v4u o; o.x = pk2(s[0 * 33], s[1 * 33]); o.y = pk2(s[2 * 33], s[3 * 33]); o.z = pk2(s[4 * 33], s[5 * 33]); o.w = pk2(s[6 * 33], s[7 * 33]);
        *(GAS v4u*)(WT + (size_t)(row_off + n0 + n) * K + k0 + 8 * c) = o; }
    LDS_WAIT(); asm volatile("" ::: "memory");
}
__device__ __forceinline__ void rms_row_to_bf16(const float* xrow, const float* w, bf16* orow, int lane) {
    const GAS f32x4* xr = (const GAS f32x4*)xrow + lane; const GAS f32x4* wr = (const GAS f32x4*)w + lane;
    f32x4 v[4]; float s = 0.f;
#pragma unroll
    for (int j = 0; j < 4; ++j) { v[j] = xr[64 * j]; s += (v[j].x * v[j].x + v[j].y * v[j].y) + (v[j].z * v[j].z + v[j].w * v[j].w); }
    const float r = 1.f / sqrtf(wave_sum(s) * (1.f / D) + EPSF);
    GAS unsigned long long* o8 = (GAS unsigned long long*)orow + lane;
#pragma unroll
    for (int j = 0; j < 4; ++j) { const f32x4 ww = wr[64 * j];
        o8[64 * j] = (unsigned long long)pk2(v[j].x * r * ww.x, v[j].y * r * ww.y) | ((unsigned long long)pk2(v[j].z * r * ww.z, v[j].w * r * ww.w) << 32); }
}

typedef GAS unsigned gu32;
#define RLX_AGENT __ATOMIC_RELAXED, __HIP_MEMORY_SCOPE_AGENT
#define XB_TMO      128
#define XB_XCNT(j)  (256  + 64 * (j))
#define XB_XSUB(j)  (1280 + 64 * (j))
#define XB_XGEN(j)  (2304 + 64 * (j))
#define XB_TOP      3328
#define XB_TOPGEN   3392
#define XCD_BAR_WORDS 3456
#define XB_SPIN_CAP (1u << 18)

__device__ __forceinline__ unsigned xb_ld(unsigned* p)              { return __hip_atomic_load(p, __ATOMIC_RELAXED, __HIP_MEMORY_SCOPE_AGENT); }
__device__ __forceinline__ unsigned xb_add(unsigned* p, unsigned v) { return __hip_atomic_fetch_add(p, v, __ATOMIC_RELAXED, __HIP_MEMORY_SCOPE_AGENT); }
__device__ __forceinline__ unsigned xb_xcc_id() { return (unsigned)__builtin_amdgcn_s_getreg((3 << 11) | 20) & 0xFu; }
#define XB_SPIN(cond, bar) do { unsigned _sp = 0; while (cond) { __builtin_amdgcn_s_sleep(1); \
    if ((++_sp & 255u) == 0u) { if (xb_ld(&(bar)[XB_TMO])) break; if (_sp > XB_SPIN_CAP) { atomicAdd(&(bar)[XB_TMO], 1u); break; } } } } while (0)

struct XcdBarrier {
    unsigned* bar; unsigned x;
    volatile LAS unsigned* st;
};

__device__ __forceinline__ XcdBarrier xcd_barrier_post(unsigned* bar, volatile LAS unsigned* st) {
    XcdBarrier b; b.bar = bar; b.x = xb_xcc_id(); b.st = st;
    if (threadIdx.x == 0) (void)xb_add(&bar[XB_XCNT(b.x)], 1u);
    return b;
}
__device__ __forceinline__ void xcd_barrier_complete(unsigned* bar, unsigned x, unsigned& nloc, unsigned& nx) {
    const unsigned G = gridDim.x * gridDim.y * gridDim.z;
    unsigned sum, cnt, mine, sp = 0u;
    for (;;) {
        sum = 0u; cnt = 0u; mine = 0u;
#pragma unroll
        for (unsigned j = 0; j < 16; ++j) { const unsigned c = xb_ld(&bar[XB_XCNT(j)]); sum += c; cnt += (c > 0u) ? 1u : 0u; mine = (j == x) ? c : mine; }
        if (sum == G) break;
        __builtin_amdgcn_s_sleep(1);
        if ((++sp & 255u) == 0u) { if (xb_ld(&bar[XB_TMO])) break; if (sp > XB_SPIN_CAP) { atomicAdd(&bar[XB_TMO], 1u); break; } }
    }
    nloc = mine > 0u ? mine : 1u; nx = cnt > 0u ? cnt : 1u;
}

__device__ __forceinline__ void xcd_barrier(const XcdBarrier& b) {
    asm volatile("s_waitcnt vmcnt(0)" ::: "memory");
    __syncthreads();
    if (threadIdx.x == 0) {
        unsigned* bar = b.bar;
        __builtin_amdgcn_s_waitcnt(0);
        unsigned nloc = b.st[0], nx = b.st[1];
        if (nloc == 0u) { xcd_barrier_complete(bar, b.x, nloc, nx); b.st[0] = nloc; b.st[1] = nx; }
        const unsigned old = xb_add(&bar[XB_XSUB(b.x)], 1u);
        const unsigned gen = old / nloc;
        if (old + 1u == (gen + 1u) * nloc) {
            __builtin_amdgcn_fence(__ATOMIC_RELEASE, "agent");
            asm volatile("s_waitcnt vmcnt(0)" ::: "memory");
            const unsigned og = xb_add(&bar[XB_TOP], 1u);
            const unsigned tg = og / nx;
            if (og + 1u == (tg + 1u) * nx) xb_add(&bar[XB_TOPGEN], 1u);
            else XB_SPIN(xb_ld(&bar[XB_TOPGEN]) == tg, bar);
            __builtin_amdgcn_fence(__ATOMIC_ACQUIRE, "agent");
            xb_add(&bar[XB_XGEN(b.x)], 1u);
            asm volatile("s_waitcnt vmcnt(0)" ::: "memory");
        } else {
            XB_SPIN(xb_ld(&bar[XB_XGEN(b.x)]) == gen, bar);
            __builtin_amdgcn_fence(__ATOMIC_ACQUIRE, "agent");
            asm volatile("s_waitcnt vmcnt(0)" ::: "memory");
        }
    }
    __syncthreads();
}

struct Args { const float* in[13]; float* out; unsigned char* ws; int ph_lo, ph_hi; };

__global__ void __launch_bounds__(NT, 2) fwd(Args a) {
    extern __shared__ __attribute__((aligned(16))) unsigned char lds[];
    LAS unsigned char* L = (LAS unsigned char*)lds;
    const int tid = threadIdx.x, lane = tid & 63, wave = __builtin_amdgcn_readfirstlane(tid >> 6), G = gridDim.x, bx = blockIdx.x;
    const int gw = bx * NWAVES + wave, NGW = G * NWAVES;
    unsigned char* ws = a.ws;
    const float* x = a.in[0]; const float* meta = a.in[1]; const float* norm_w = a.in[2]; const float* w_in = a.in[3]; const float* b_in = a.in[4];
    const float* lb_logits = a.in[5]; const float* hg_norm_w = a.in[6]; const float* pool_w = a.in[7]; const float* pool_scale = a.in[8];
    const float* w_hg = a.in[9]; const float* w_pool = a.in[10]; const float* w_out = a.in[11]; const float* fin_w = a.in[12];
    float* PMETA = (float*)(ws + WS_PMETA); float* S0 = (float*)(ws + WS_S0); float* DL = (float*)(ws + WS_DL); float* BIASP = (float*)(ws + WS_BIASP);
    bf16* HM = (bf16*)(ws + WS_HM); bf16* WHG = (bf16*)(ws + WS_WHG); bf16* WPOOL = (bf16*)(ws + WS_WPOOL); bf16* WOUT = (bf16*)(ws + WS_WOUT); bf16* WIN = (bf16*)(ws + WS_WIN);
    bf16* Hb = (bf16*)(ws + WS_H); bf16* Qb = (bf16*)(ws + WS_Q); bf16* Kb = (bf16*)(ws + WS_K); bf16* Vb = (bf16*)(ws + WS_V); bf16* SGb = (bf16*)(ws + WS_SG);
    bf16* Ub = (bf16*)(ws + WS_U); bf16* SGPb = (bf16*)(ws + WS_SGP); bf16* S1b = (bf16*)(ws + WS_S1); bf16* S2b = (bf16*)(ws + WS_S2); bf16* MRG = (bf16*)(ws + WS_MRG); bf16* Y1b = (bf16*)(ws + WS_Y1);
    bf16* ST = (bf16*)a.out;
    const int lo = a.ph_lo, hi = a.ph_hi;
    volatile LAS unsigned* MISC = (volatile LAS unsigned*)(L + MISC_OFF);
    if (tid < 64) MISC[tid] = 0u;
    __syncthreads();
    XcdBarrier bar = xcd_barrier_post((unsigned*)(ws + WS_CTL) + CW_BAR, MISC + 8);
#define GRID_BAR(k) do { if (IN(k) && IN((k) + 1)) xcd_barrier(bar); } while (0)
#define IN(k) (lo <= (k) && (k) < hi)

    if (IN(0)) {
        LAS float* scr = (LAS float*)(L + wave * 16384);
        constexpr int I_IN = 16 * 256, I_SQ = 16 * 32;
        for (int it = gw; it < I_IN + 3 * I_SQ; it += NGW) {
            int r = it;
            if (r < I_IN) { const int nb = r % 256; if (nb >= 128 && nb < 160) continue; p0_transpose_item(w_in, D, NCOL, 256, WIN, 0, scr, r, lane); continue; } r -= I_IN;
            if (r < I_SQ) { p0_transpose_item(w_hg, D, D, 32, WHG, 0, scr, r, lane); continue; } r -= I_SQ;
            if (r < I_SQ) { p0_transpose_item(w_pool, D, D, 32, WPOOL, 0, scr, r, lane); continue; } r -= I_SQ;
            p0_transpose_item(w_out, D, D, 32, WOUT, 0, scr, r, lane);
        }
        LAS float* tile = (LAS float*)(L + 131072);
        for (int item = bx; item < 256; item += G) {
            const int g = item >> 6, k0 = 16 * (item & 63);
            __syncthreads();
#pragma unroll
            for (int j = 0; j < 8; ++j) { const int idx = j * NT + tid, kk = idx >> 8, c = idx & 255; tile[idx] = w_in[(size_t)(k0 + kk) * NCOL + 4096 + g * 256 + c]; }
            __syncthreads();
            const int d = tid & 255, kh = tid >> 8;
            float acc[8];
#pragma unroll
            for (int i = 0; i < 8; ++i) acc[i] = 0.f;
            const float* pw = pool_w + (size_t)g * 65536 + d;
            for (int c4 = 0; c4 < 64; ++c4) {
                const float p0 = pw[(4 * c4 + 0) * 256], p1 = pw[(4 * c4 + 1) * 256], p2 = pw[(4 * c4 + 2) * 256], p3 = pw[(4 * c4 + 3) * 256];
#pragma unroll
                for (int i = 0; i < 8; ++i) { const f32x4 t4 = *(const LAS f32x4*)(tile + (kh * 8 + i) * 256 + 4 * c4); acc[i] += (t4.x * p0 + t4.y * p1) + (t4.z * p2 + t4.w * p3); }
            }
            v4u o; o.x = pk2(acc[0], acc[1]); o.y = pk2(acc[2], acc[3]); o.z = pk2(acc[4], acc[5]); o.w = pk2(acc[6], acc[7]);
            *(GAS v4u*)(WIN + (size_t)(4096 + g * 256 + d) * D + k0 + kh * 8) = o;
        }
        { const int n = bx * NT + tid;
          if (n < NCOL) { float bv;
              if (n >= 4096 && n < 5120) { const int g = (n - 4096) >> 8, d = n & 255; float s = 0.f; for (int c = 0; c < 256; ++c) s += b_in[4096 + g * 256 + c] * pool_w[(size_t)g * 65536 + c * 256 + d]; bv = s; }
              else bv = b_in[n];
              BIASP[n] = bv; } }
        for (int m = gw; m < M; m += NGW) rms_row_to_bf16(x + (size_t)m * D, norm_w, Hb + (size_t)m * D, lane);
        if (gw < NMETA) rms_row_to_bf16(meta + (size_t)gw * D, norm_w, HM + (size_t)gw * D, lane);
    }
    GRID_BAR(0);
    if (IN(1)) {
        for (int o = bx * NT + tid; o < NMETA * NCOL; o += G * NT) { const int col = o >> 4, row = o & 15;
            const v4u* wrow = (const v4u*)(WIN + (size_t)col * D); const v4u* hrow = (const v4u*)(HM + (size_t)row * D); float s = 0.f;
            for (int k8 = 0; k8 < 128; ++k8) { const v4u w = wrow[k8], h = hrow[k8];
                s += (blo(w.x) * blo(h.x) + bhi(w.x) * bhi(h.x)) + (blo(w.y) * blo(h.y) + bhi(w.y) * bhi(h.y)) + (blo(w.z) * blo(h.z) + bhi(w.z) * bhi(h.z)) + (blo(w.w) * blo(h.w) + bhi(w.w) * bhi(h.w)); }
            PMETA[(size_t)row * NCOL + col] = s + BIASP[col]; }
        pg8::Gemm g{Hb, WIN, M, 6144, D}; pg8::StaticOrder S; S.init(M, 6144, G, bx);
        pg8::EpiBf16<0> E{Qb, D, BIASP, D, (size_t)(WS_K - WS_Q) / 2};
        pg8::gemm_phase<pg8::EpiBf16<0>, pg8::StaticOrder, PG8_ALIGN, PG8_SP2>(L, g, S, E);
    }
    GRID_BAR(1);
    if (IN(2)) {
        for (int strip = bx * NT + tid; strip < NCH_ALL * 256; strip += G * NT) { const int chunk = strip >> 8, c4 = (strip & 255) * 4;
            float lbv[4], bs[4];
#pragma unroll
            for (int j = 0; j < 4; ++j) { lbv[j] = 1.0f / (1.0f + __expf(lb_logits[D + c4 + j] - lb_logits[c4 + j])); bs[j] = 0.f; }
#pragma unroll 1
            for (int sb = 0; sb < 4; ++sb) { v2u qq[16], ff[16]; const size_t i0 = (size_t)(chunk * CH + sb * 16) * D + c4;
#pragma unroll
                for (int r = 0; r < 16; ++r) { qq[r] = *(const v2u*)(Qb + i0 + (size_t)r * D); ff[r] = *(const v2u*)(Kb + i0 + (size_t)r * D); }
#pragma unroll
                for (int r = 0; r < 16; ++r) { const float qv[4] = {blo(qq[r].x), bhi(qq[r].x), blo(qq[r].y), bhi(qq[r].y)}, fv[4] = {blo(ff[r].x), bhi(ff[r].x), blo(ff[r].y), bhi(ff[r].y)}; float qo[4], ko[4];
#pragma unroll
                    for (int j = 0; j < 4; ++j) { const float sg = sigmf(fv[j]), f = lbv[j] + (1.f - lbv[j]) * sg; bs[j] += __logf(f); qo[j] = qv[j] * __expf(bs[j]); ko[j] = (1.f - lbv[j]) * (1.f - sg) * __expf(-bs[j]); }
                    v2u o; o.x = pg8::cvt_pk_bf16(qo[0], qo[1]); o.y = pg8::cvt_pk_bf16(qo[2], qo[3]); *(v2u*)(Qb + i0 + (size_t)r * D) = o;
                    o.x = pg8::cvt_pk_bf16(ko[0], ko[1]); o.y = pg8::cvt_pk_bf16(ko[2], ko[3]); *(v2u*)(Kb + i0 + (size_t)r * D) = o; } }
            *(f32x4*)(DL + (size_t)chunk * D + c4) = (f32x4){__expf(bs[0]), __expf(bs[1]), __expf(bs[2]), __expf(bs[3])}; }
        for (int o = bx * NT + tid; o < NH * DK * DV; o += G * NT) { const int h = o >> 14, k = (o >> 7) & 127, v = o & 127, col = h * 128 + k;
            const float lb = 1.0f / (1.0f + __expf(lb_logits[D + col] - lb_logits[col])); float b = 0.f, s0 = 0.f;
            for (int s = 0; s < NMETA; ++s) { const float fz = PMETA[(size_t)s * NCOL + 1024 + col]; const float sg = sigmf(fz), f = lb + (1.f - lb) * sg;
                b += __logf(f); s0 += (1.f - lb) * (1.f - sg) * __expf(-b) * PMETA[(size_t)s * NCOL + 2048 + h * 128 + v]; }
            S0[o] = __expf(b) * s0; }
        for (int o = bx * NT + tid; o < M * (D / 8); o += G * NT) { const int row = o >> 7, c0 = (o & 127) * 8, i = row & (SEQ - 1), w = 2 << (c0 >> 8);
            float sum[8];
#pragma unroll
            for (int j = 0; j < 8; ++j) sum[j] = 0.f;
            for (int jj = 0; jj < w; ++jj) { const int ii = i - jj;
                if (ii >= 0) { const v4u t = *(const v4u*)(Ub + (size_t)(row - jj) * D + c0);
                    sum[0] += blo(t.x); sum[1] += bhi(t.x); sum[2] += blo(t.y); sum[3] += bhi(t.y); sum[4] += blo(t.z); sum[5] += bhi(t.z); sum[6] += blo(t.w); sum[7] += bhi(t.w); }
                else { const float* pm = PMETA + (size_t)(NMETA + ii) * NCOL + 4096 + c0;
#pragma unroll
                    for (int j = 0; j < 8; ++j) sum[j] += pm[j]; } }
            const v4u cur = *(const v4u*)(Ub + (size_t)row * D + c0); const v4u gp = *(const v4u*)(SGPb + (size_t)row * D + c0);
            const float cu[8] = {blo(cur.x), bhi(cur.x), blo(cur.y), bhi(cur.y), blo(cur.z), bhi(cur.z), blo(cur.w), bhi(cur.w)};
            const float gv[8] = {blo(gp.x), bhi(gp.x), blo(gp.y), bhi(gp.y), blo(gp.z), bhi(gp.z), blo(gp.w), bhi(gp.w)};
            const float inv = 1.0f / (float)w; float r[8];
#pragma unroll
            for (int j = 0; j < 8; ++j) r[j] = (sum[j] * inv - cu[j]) * pool_scale[c0 + j] * (gv[j] * sigmf(gv[j]));
            v4u ov; ov.x = pk2(r[0], r[1]); ov.y = pk2(r[2], r[3]); ov.z = pk2(r[4], r[5]); ov.w = pk2(r[6], r[7]);
            *(v4u*)(SGPb + (size_t)row * D + c0) = ov; }
    }
    GRID_BAR(2);
    if (IN(3)) {
        constexpr int KVB = 2048 + 64 * 288;
        const int i16 = lane & 15, g = lane >> 4, q4 = i16 >> 2, p4 = i16 & 3;
        for (int item = bx; item < BATCH * NH * 8; item += G) {
            const int bh = item >> 3, ks = item & 7, b = bh >> 3, h = bh & 7;
            f32x4 acc;
#pragma unroll
            for (int r = 0; r < 4; ++r) acc[r] = S0[(size_t)h * 16384 + (16 * ks + 4 * g + r) * 128 + 16 * wave + i16];
            const bf16* ksrc = Kb + (size_t)(b * SEQ + (tid >> 1)) * D + h * 128 + 16 * ks + 8 * (tid & 1);
            const bf16* vsrc0 = Vb + (size_t)(b * SEQ + (tid >> 4)) * D + h * 128 + 8 * (tid & 15);
            const bf16* vsrc1 = vsrc0 + (size_t)32 * D;
            const int kdst = (tid >> 1) * 32 + (tid & 1) * 16, vdst0 = 2048 + (tid >> 4) * 288 + (tid & 15) * 16, vdst1 = vdst0 + 32 * 288;
            v4u rk[2], rv0[2], rv1[2];
            __syncthreads();
            if (tid < 128) rk[0] = *(const v4u*)ksrc; rv0[0] = *(const v4u*)vsrc0; rv1[0] = *(const v4u*)vsrc1;
            if (tid < 128) rk[1] = *(const v4u*)(ksrc + (size_t)CH * D); rv0[1] = *(const v4u*)(vsrc0 + (size_t)CH * D); rv1[1] = *(const v4u*)(vsrc1 + (size_t)CH * D);
            if (tid < 128) *(LAS v4u*)(L + kdst) = rk[0]; *(LAS v4u*)(L + vdst0) = rv0[0]; *(LAS v4u*)(L + vdst1) = rv1[0];
            __syncthreads();
#pragma unroll 1
            for (int c = 0; c < NCHUNK; c += 2) {
#pragma unroll
                for (int u = 0; u < 2; ++u) {
                    const int cc = c + u;
                    if (cc + 2 < NCHUNK) { const size_t o2 = (size_t)(cc + 2) * CH * D;
                        if (tid < 128) rk[u] = *(const v4u*)(ksrc + o2); rv0[u] = *(const v4u*)(vsrc0 + o2); rv1[u] = *(const v4u*)(vsrc1 + o2); }
                    LAS unsigned char* B0 = L + u * KVB;
                    { v2u o; o.x = pg8::cvt_pk_bf16(acc[0], acc[1]); o.y = pg8::cvt_pk_bf16(acc[2], acc[3]);
                      *(v2u*)(ST + ((size_t)(bh * NCHUNK + cc) * 128 + 16 * wave + i16) * 128 + 16 * ks + 4 * g) = o; }
                    const f32x4 dl = *(const f32x4*)(DL + (size_t)(b * NCHUNK + cc) * D + h * 128 + 16 * ks + 4 * g);
#pragma unroll
                    for (int j = 0; j < 2; ++j) {
                        const int row = 32 * j + 8 * g + q4;
                        const tr4 a0 = __builtin_amdgcn_ds_read_tr16_b64_v4i16((LAS tr4*)(B0 + row * 32 + 8 * p4));
                        const tr4 a1 = __builtin_amdgcn_ds_read_tr16_b64_v4i16((LAS tr4*)(B0 + (row + 4) * 32 + 8 * p4));
                        const tr4 b0 = __builtin_amdgcn_ds_read_tr16_b64_v4i16((LAS tr4*)(B0 + 2048 + row * 288 + 32 * wave + 8 * p4));
                        const tr4 b1 = __builtin_amdgcn_ds_read_tr16_b64_v4i16((LAS tr4*)(B0 + 2048 + (row + 4) * 288 + 32 * wave + 8 * p4));
                        const pg8::bf16x8 af = __builtin_shufflevector(a0, a1, 0, 1, 2, 3, 4, 5, 6, 7), bfr = __builtin_shufflevector(b0, b1, 0, 1, 2, 3, 4, 5, 6, 7);
                        acc = __builtin_amdgcn_mfma_f32_16x16x32_bf16(af, bfr, acc, 0, 0, 0);
                    }
                    acc = acc * dl;
                    if (cc + 1 < NCHUNK) { LAS unsigned char* B1 = L + (u ^ 1) * KVB;
                        if (tid < 128) *(LAS v4u*)(B1 + kdst) = rk[u ^ 1]; *(LAS v4u*)(B1 + vdst0) = rv0[u ^ 1]; *(LAS v4u*)(B1 + vdst1) = rv1[u ^ 1]; }
                    __syncthreads();
                }
            }
        }
    }
    GRID_BAR(3);
    if (IN(4)) {
        constexpr int QS = 272, VS = 288, AS = 144;
        constexpr int QOFF = 0, KOFF = 64 * QS, VOFF = KOFF + 64 * QS, SOFF = VOFF + 64 * VS, AOFF = SOFF + 128 * QS, ROFF = AOFF + 64 * AS;
        static_assert(ROFF + 512 <= 131072, "stage O LDS");
        const int i16 = lane & 15, g = lane >> 4, q4 = i16 >> 2, p4 = i16 & 3, ti = wave & 3, vh = wave >> 2;
        LAS float* red = (LAS float*)(L + ROFF);
        for (int unit = bx; unit < BATCH * NH * NCHUNK; unit += G) { const int c = unit & 63, bh = unit >> 6, b = bh >> 3, h = bh & 7; const size_t r0 = (size_t)(b * SEQ + c * CH);
            __syncthreads();
#pragma unroll
            for (int j = 0; j < 2; ++j) { const int p = j * NT + tid, row = p >> 4, ch = p & 15; const size_t go = (r0 + row) * D + h * 128 + ch * 8;
                *(LAS v4u*)(L + QOFF + row * QS + ch * 16) = *(const v4u*)(Qb + go); *(LAS v4u*)(L + KOFF + row * QS + ch * 16) = *(const v4u*)(Kb + go); *(LAS v4u*)(L + VOFF + row * VS + ch * 16) = *(const v4u*)(Vb + go); }
#pragma unroll
            for (int j = 0; j < 4; ++j) { const int p = j * NT + tid, row = p >> 4, ch = p & 15; *(LAS v4u*)(L + SOFF + row * QS + ch * 16) = *(const v4u*)(ST + (size_t)unit * 16384 + p * 8); }
            __syncthreads();
            pg8::bf16x8 qf[4];
#pragma unroll
            for (int kk = 0; kk < 4; ++kk) qf[kk] = *(const LAS pg8::bf16x8*)(L + QOFF + (16 * ti + i16) * QS + kk * 64 + g * 16);
#pragma unroll
            for (int e = 0; e < 2; ++e) { const int sj = 2 * vh + e; f32x4 at = {0.f, 0.f, 0.f, 0.f};
                if (sj <= ti) {
#pragma unroll
                    for (int kk = 0; kk < 4; ++kk) { const pg8::bf16x8 kf = *(const LAS pg8::bf16x8*)(L + KOFF + (16 * sj + i16) * QS + kk * 64 + g * 16); at = __builtin_amdgcn_mfma_f32_16x16x32_bf16(kf, qf[kk], at, 0, 0, 0); }
                    if (sj == ti) {
#pragma unroll
                        for (int r = 0; r < 4; ++r) if (4 * g + r > i16) at[r] = 0.f; }
                }
                v2u o; o.x = pg8::cvt_pk_bf16(at[0], at[1]); o.y = pg8::cvt_pk_bf16(at[2], at[3]);
                *(LAS v2u*)(L + AOFF + (16 * ti + i16) * AS + (16 * sj + 4 * g) * 2) = o; }
            __syncthreads();
            f32x4 oc[4];
#pragma unroll
            for (int vt = 0; vt < 4; ++vt) { oc[vt] = (f32x4){0.f, 0.f, 0.f, 0.f};
#pragma unroll
                for (int kk = 0; kk < 4; ++kk) { const pg8::bf16x8 sf = *(const LAS pg8::bf16x8*)(L + SOFF + (64 * vh + 16 * vt + i16) * QS + kk * 64 + g * 16); oc[vt] = __builtin_amdgcn_mfma_f32_16x16x32_bf16(sf, qf[kk], oc[vt], 0, 0, 0); } }
#pragma unroll
            for (int j = 0; j < 2; ++j) if (2 * j <= ti) {
                const pg8::bf16x8 afr = *(const LAS pg8::bf16x8*)(L + AOFF + (16 * ti + i16) * AS + j * 64 + g * 16);
                const int row = 32 * j + 8 * g + q4;
#pragma unroll
                for (int vt = 0; vt < 4; ++vt) { const int cb = (64 * vh + 16 * vt + 4 * p4) * 2;
                    const tr4 v0 = __builtin_amdgcn_ds_read_tr16_b64_v4i16((LAS tr4*)(L + VOFF + row * VS + cb));
                    const tr4 v1 = __builtin_amdgcn_ds_read_tr16_b64_v4i16((LAS tr4*)(L + VOFF + (row + 4) * VS + cb));
                    const pg8::bf16x8 vf = __builtin_shufflevector(v0, v1, 0, 1, 2, 3, 4, 5, 6, 7);
                    oc[vt] = __builtin_amdgcn_mfma_f32_16x16x32_bf16(vf, afr, oc[vt], 0, 0, 0); } }
            float ssq = 0.f;
#pragma unroll
            for (int vt = 0; vt < 4; ++vt) ssq += (oc[vt][0] * oc[vt][0] + oc[vt][1] * oc[vt][1]) + (oc[vt][2] * oc[vt][2] + oc[vt][3] * oc[vt][3]);
            ssq += __shfl_xor(ssq, 16); ssq += __shfl_xor(ssq, 32);
            if (g == 0) red[vh * 64 + 16 * ti + i16] = ssq;
            __syncthreads();
            const float rr = 1.f / sqrtf((red[16 * ti + i16] + red[64 + 16 * ti + i16]) * (1.f / 128.f) + EPSF);
            bf16* gp = SGb + (r0 + 16 * ti + i16) * D + h * 128 + 64 * vh + 4 * g;
#pragma unroll
            for (int vt = 0; vt < 4; ++vt) { const v2u gw2 = *(const v2u*)(gp + 16 * vt); const f32x4 hw = *(const f32x4*)(hg_norm_w + h * 128 + 64 * vh + 16 * vt + 4 * g);
                const float g0 = blo(gw2.x), g1 = bhi(gw2.x), g2 = blo(gw2.y), g3 = bhi(gw2.y);
                v2u o; o.x = pg8::cvt_pk_bf16(oc[vt][0] * rr * hw.x * (g0 * sigmf(g0)), oc[vt][1] * rr * hw.y * (g1 * sigmf(g1)));
                o.y = pg8::cvt_pk_bf16(oc[vt][2] * rr * hw.z * (g2 * sigmf(g2)), oc[vt][3] * rr * hw.w * (g3 * sigmf(g3)));
                *(v2u*)(gp + 16 * vt) = o; }
        }
    }
    GRID_BAR(4);
    if (IN(5)) {
        pg8::Gemm g{Hb, WIN + (size_t)6144 * D, M, 2048, D}; pg8::StaticOrder S; S.init(M, 2048, G, bx);
        pg8::EpiBf16<3> E{S1b, D, BIASP + 6144, D, (size_t)(WS_S2 - WS_S1) / 2};
        pg8::gemm_phase<pg8::EpiBf16<3>, pg8::StaticOrder, PG8_ALIGN, PG8_SP2>(L, g, S, E);
    }
    GRID_BAR(5);
    if (IN(6)) {
        pg8::Gemm g{SGb, WHG, M, D, D}; pg8::StaticOrder S; S.init(M, D, G, bx);
        pg8::EpiGate<0> E{Y1b, S1b, nullptr, D};
        pg8::gemm_phase<pg8::EpiGate<0>, pg8::StaticOrder, PG8_ALIGN, PG8_SP2>(L, g, S, E);
    }
    GRID_BAR(6);
    if (IN(7)) {
        pg8::Gemm g{SGPb, WPOOL, M, D, D}; pg8::StaticOrder S; S.init(M, D, G, bx);
        pg8::EpiGate<1> E{MRG, S2b, Y1b, D};
        pg8::gemm_phase<pg8::EpiGate<1>, pg8::StaticOrder, PG8_ALIGN, PG8_SP2>(L, g, S, E);
    }
    GRID_BAR(7);
    if (IN(8)) {
        pg8::Gemm g{MRG, WOUT, M, D, D}; pg8::StaticOrder S; S.init(M, D, G, bx);
        pg8::EpiRes E{x, a.out, D};
        pg8::gemm_phase<pg8::EpiRes, pg8::StaticOrder, PG8_ALIGN, PG8_SP2>(L, g, S, E);
    }
    GRID_BAR(8);
    if (IN(9)) {
        for (int m = gw; m < M; m += NGW) { GAS f32x4* zr = (GAS f32x4*)(a.out + (size_t)m * D) + lane; const GAS f32x4* wr = (const GAS f32x4*)fin_w + lane;
            f32x4 v[4]; float s = 0.f;
#pragma unroll
            for (int j = 0; j < 4; ++j) { v[j] = zr[64 * j]; s += (v[j].x * v[j].x + v[j].y * v[j].y) + (v[j].z * v[j].z + v[j].w * v[j].w); }
            const float ms = wave_sum(s) * (1.f / D); const float r = 1.f / sqrtf(ms + EPSF);
#pragma unroll
            for (int j = 0; j < 4; ++j) zr[64 * j] = v[j] * r * wr[64 * j]; }
    }

#undef IN
}

constexpr int N_PHASES = 10;
extern "C" void kernel_launch(void* const* d_in, const int* in_sizes, int n_in, void* d_out, int out_size, void* d_ws, size_t ws_size, hipStream_t stream) {
    static int grid = 0;
    if (grid == 0) {
        if (n_in != 13 || out_size != M * D || ws_size < WS_END) { fprintf(stderr, "kernel_launch: unexpected shapes n_in %d out %d ws %zu\n", n_in, out_size, ws_size); grid = -1; return; }
        if (hipFuncSetAttribute((const void*)fwd, hipFuncAttributeMaxDynamicSharedMemorySize, LDS_BYTES) != hipSuccess) { fprintf(stderr, "kernel_launch: hipFuncSetAttribute failed\n"); grid = -1; return; }
        int dev = 0, cus = 0; if (hipGetDevice(&dev) != hipSuccess || hipDeviceGetAttribute(&cus, hipDeviceAttributeMultiprocessorCount, dev) != hipSuccess || cus < 8) { fprintf(stderr, "kernel_launch: device query failed\n"); grid = -1; return; }
        grid = cus;
    }
    if (grid < 0) return;
    Args a{};
    for (int i = 0; i < 13; ++i) a.in[i] = (const float*)d_in[i];
    a.out = (float*)d_out; a.ws = (unsigned char*)d_ws;
    if (hipMemsetAsync((char*)d_ws + WS_CTL, 0, CTL_ZERO_BYTES, stream) != hipSuccess) { fprintf(stderr, "kernel_launch: memset failed\n"); return; }
    a.ph_lo = 0; a.ph_hi = N_PHASES;
    hipLaunchKernelGGL(fwd, dim3(grid), dim3(NT), LDS_BYTES, stream, a);
}
```
